# Optimizing an MI355X kernel written in HIP

```python
import math
import jax, jax.numpy as jnp
from jax import lax
import numpy as np

D_MODEL = 2048
BATCH = 2
SEQ = 4096
DEPTH = 4

GRID_W = 64
N_HEADS = 8
N_KV_HEADS = 2
GQA = N_HEADS // N_KV_HEADS
HEAD_DIM = 128
ATTN_WIDTH = N_HEADS * HEAD_DIM
KV_WIDTH = N_KV_HEADS * HEAD_DIM
Q_BLOCK = 128
ROPE_THETA = 10000.0
ROPE_AXIS_PAIRS = HEAD_DIM // 4
SSM_WIDTH = D_MODEL // 2
SSM_CH = 16
SSM_GROUPS = SSM_WIDTH // SSM_CH
SSM_STATE = 64
SSM_DT_MIN = 1e-3
SSM_DT_MAX = 1e-1
D_MIX = ATTN_WIDTH + SSM_WIDTH
D_IN_PROJ = ATTN_WIDTH + 2 * KV_WIDTH + SSM_WIDTH
N_EXPERT_GROUPS = 4
EXPERTS_PER_GROUP = 4
N_EXPERTS = N_EXPERT_GROUPS * EXPERTS_PER_GROUP
TOP_K_INNER = 2
D_EXPERT = 512
PLE_DIM = 256
ALPHA = (2 * DEPTH) ** 0.25
BETA = (8 * DEPTH) ** -0.25
EPS = 1e-6

kernel_name = "hybrid_attn_s5_hmoe_encoder"


def layer_norm(x, g, b):
    xf = x.astype(jnp.float32)
    mu = jnp.mean(xf, axis=-1, keepdims=True)
    var = jnp.mean(jnp.square(xf - mu), axis=-1, keepdims=True)
    y = (xf - mu) * lax.rsqrt(var + EPS)
    return (y * g.astype(jnp.float32) + b.astype(jnp.float32)).astype(x.dtype)


def rms_norm(x, g):
    xf = x.astype(jnp.float32)
    y = xf * lax.rsqrt(jnp.mean(jnp.square(xf), axis=-1, keepdims=True) + EPS)
    return (y * g.astype(jnp.float32)).astype(x.dtype)


def axial_rope_tables(seq_len, dtype):
    rows = seq_len // GRID_W
    row = jnp.repeat(jnp.arange(rows, dtype=jnp.float32), GRID_W)
    col = jnp.tile(jnp.arange(GRID_W, dtype=jnp.float32), rows)
    inv_freq = ROPE_THETA ** (-jnp.arange(ROPE_AXIS_PAIRS, dtype=jnp.float32) / ROPE_AXIS_PAIRS)
    ang = jnp.concatenate([row[:, None] * inv_freq, col[:, None] * inv_freq], axis=-1)
    return jnp.cos(ang).astype(dtype), jnp.sin(ang).astype(dtype)


def apply_rope(x, cos, sin):
    half = HEAD_DIM // 2
    x1, x2 = x[..., :half], x[..., half:]
    c, s = cos[:, None, :], sin[:, None, :]
    return jnp.concatenate([x1 * c - x2 * s, x2 * c + x1 * s], axis=-1)


def block_attention(q, k, v):
    bsz, s_len, _, _ = q.shape
    nb = s_len // Q_BLOCK
    qb = q.reshape(bsz, nb, Q_BLOCK, N_KV_HEADS, GQA, HEAD_DIM).transpose(1, 0, 2, 3, 4, 5)
    scale = HEAD_DIM ** -0.5

    def one_block(qblk):
        s = jnp.einsum('bqgrd,bkgd->bgrqk', qblk, k).astype(jnp.float32) * scale
        pr = jax.nn.softmax(s, axis=-1).astype(v.dtype)
        return jnp.einsum('bgrqk,bkgd->bqgrd', pr, v)

    o = lax.map(one_block, qb)
    return o.transpose(1, 0, 2, 3, 4, 5).reshape(bsz, s_len, ATTN_WIDTH)


def s5_direction(u, a_re, a_im, log_dt, b_re, b_im, c_re, c_im, reverse):
    dt = jnp.exp(log_dt)[:, None]
    mag = jnp.exp(dt * a_re)
    ang = dt * a_im
    abar_re, abar_im = mag * jnp.cos(ang), mag * jnp.sin(ang)
    den = a_re * a_re + a_im * a_im
    nr, ni = abar_re - 1.0, abar_im
    coef_re = (nr * a_re + ni * a_im) / den
    coef_im = (ni * a_re - nr * a_im) / den
    bb_re = coef_re[..., None] * b_re - coef_im[..., None] * b_im
    bb_im = coef_re[..., None] * b_im + coef_im[..., None] * b_re
    bu_re = jnp.einsum('bsgh,gph->bsgp', u, bb_re)
    bu_im = jnp.einsum('bsgh,gph->bsgp', u, bb_im)
    ar = jnp.broadcast_to(abar_re, bu_re.shape)
    ai = jnp.broadcast_to(abar_im, bu_re.shape)

    def combine(e1, e2):
        a1r, a1i, b1r, b1i = e1
        a2r, a2i, b2r, b2i = e2
        return (a2r * a1r - a2i * a1i,
                a2r * a1i + a2i * a1r,
                a2r * b1r - a2i * b1i + b2r,
                a2r * b1i + a2i * b1r + b2i)

    _, _, xr, xi = lax.associative_scan(combine, (ar, ai, bu_re, bu_im), axis=1, reverse=reverse)
    return jnp.einsum('bsgp,ghp->bsgh', xr, c_re) - jnp.einsum('bsgp,ghp->bsgh', xi, c_im)


def hybrid_mixer(h, cos, sin, w_in, q_norm_g, k_norm_g, a_re, a_im, log_dt, b_re, b_im,
                 c_re, c_im, d_skip, w_glu, b_glu, attn_out_g, ssm_out_g, w_out):
    bsz, s_len, _ = h.shape
    z = h @ w_in
    q, k, v, u = jnp.split(z, [ATTN_WIDTH, ATTN_WIDTH + KV_WIDTH, ATTN_WIDTH + 2 * KV_WIDTH], axis=-1)
    q = apply_rope(rms_norm(q.reshape(bsz, s_len, N_HEADS, HEAD_DIM), q_norm_g), cos, sin)
    k = apply_rope(rms_norm(k.reshape(bsz, s_len, N_KV_HEADS, HEAD_DIM), k_norm_g), cos, sin)
    v = v.reshape(bsz, s_len, N_KV_HEADS, HEAD_DIM)
    attn = block_attention(q, k, v)
    us = u.reshape(bsz, s_len, SSM_GROUPS, SSM_CH)
    y = (s5_direction(us, a_re[0], a_im[0], log_dt[0], b_re[0], b_im[0], c_re[0], c_im[0], False)
         + s5_direction(us, a_re[1], a_im[1], log_dt[1], b_re[1], b_im[1], c_re[1], c_im[1], True)
         + us * d_skip)
    y = jax.nn.gelu(y.reshape(bsz, s_len, SSM_WIDTH))
    y = y * jax.nn.sigmoid(y @ w_glu + b_glu)
    cat = jnp.concatenate([rms_norm(attn, attn_out_g), rms_norm(y, ssm_out_g)], axis=-1)
    return cat @ w_out


def hierarchical_moe(x, rg_w, rg_b, re_w, re_b, w_gate, w_up, w_down):
    bsz, s_len, d = x.shape
    t = x.reshape(bsz * s_len, d)
    g_prob = jax.nn.softmax((t @ rg_w + rg_b).astype(jnp.float32), axis=-1)
    g_top, g_idx = lax.top_k(g_prob, 1)
    e_logits = (t @ re_w + re_b).astype(jnp.float32).reshape(-1, N_EXPERT_GROUPS, EXPERTS_PER_GROUP)
    sel = jnp.take_along_axis(e_logits, g_idx[:, :, None], axis=1)[:, 0]
    e_top, e_idx = lax.top_k(jax.nn.softmax(sel, axis=-1), TOP_K_INNER)
    e_w = e_top / jnp.sum(e_top, axis=-1, keepdims=True)
    gates = g_top * e_w
    global_idx = g_idx * EXPERTS_PER_GROUP + e_idx
    combine = jnp.sum(jax.nn.one_hot(global_idx, N_EXPERTS, dtype=jnp.float32) * gates[..., None], axis=1)
    combine = combine.astype(x.dtype)
    hid = jax.nn.silu(jnp.einsum('td,edf->etf', t, w_gate)) * jnp.einsum('td,edf->etf', t, w_up)
    hid = hid * combine.T[:, :, None]
    out = jnp.einsum('etf,efd->td', hid, w_down)
    return out.reshape(bsz, s_len, d)


def setup_inputs(seed: int = 0) -> dict:
    key = jax.random.key(seed)
    ks = jax.random.split(key, 40)
    f32 = jnp.float32
    L, D, G, P, H = DEPTH, D_MODEL, SSM_GROUPS, SSM_STATE, SSM_CH
    nrm = lambda k, shape, s: jax.random.normal(k, shape, f32) * s
    n_idx = jnp.arange(P, dtype=f32)
    a_re = -0.5 * jnp.exp(nrm(ks[6], (L, 2, G, P), 0.05))
    a_im = math.pi * n_idx + nrm(ks[7], (L, 2, G, P), 0.01)
    log_dt = jax.random.uniform(ks[8], (L, 2, G), f32, math.log(SSM_DT_MIN), math.log(SSM_DT_MAX))
    return {
        "x": nrm(ks[0], (BATCH, SEQ, D), 1.0),
        "p": nrm(ks[1], (DEPTH, BATCH, SEQ, PLE_DIM), 1.0),
        "ln0_g": 1.0 + nrm(ks[2], (D,), 0.02),
        "ln0_b": nrm(ks[3], (D,), 0.02),
        "w_in": nrm(ks[4], (L, D, D_IN_PROJ), D ** -0.5),
        "q_norm_g": 1.0 + nrm(ks[5], (L, HEAD_DIM), 0.02),
        "k_norm_g": 1.0 + nrm(ks[9], (L, HEAD_DIM), 0.02),
        "ssm_a_re": a_re,
        "ssm_a_im": a_im,
        "ssm_log_dt": log_dt,
        "ssm_b_re": nrm(ks[10], (L, 2, G, P, H), (2 * H) ** -0.5),
        "ssm_b_im": nrm(ks[11], (L, 2, G, P, H), (2 * H) ** -0.5),
        "ssm_c_re": nrm(ks[12], (L, 2, G, H, P), (2 * P) ** -0.5),
        "ssm_c_im": nrm(ks[13], (L, 2, G, H, P), (2 * P) ** -0.5),
        "ssm_d": nrm(ks[14], (L, G, H), 1.0),
        "w_glu": nrm(ks[15], (L, SSM_WIDTH, SSM_WIDTH), SSM_WIDTH ** -0.5),
        "b_glu": nrm(ks[16], (L, SSM_WIDTH), 0.02),
        "attn_out_g": 1.0 + nrm(ks[17], (L, ATTN_WIDTH), 0.02),
        "ssm_out_g": 1.0 + nrm(ks[18], (L, SSM_WIDTH), 0.02),
        "w_out": nrm(ks[19], (L, D_MIX, D), BETA * D_MIX ** -0.5),
        "ln1_g": 1.0 + nrm(ks[20], (L, D), 0.02),
        "ln1_b": nrm(ks[21], (L, D), 0.02),
        "router_group_w": nrm(ks[22], (L, D, N_EXPERT_GROUPS), D ** -0.5),
        "router_group_b": nrm(ks[23], (L, N_EXPERT_GROUPS), 0.01),
        "router_expert_w": nrm(ks[24], (L, D, N_EXPERTS), D ** -0.5),
        "router_expert_b": nrm(ks[25], (L, N_EXPERTS), 0.01),
        "w_gate_e": nrm(ks[26], (L, N_EXPERTS, D, D_EXPERT), D ** -0.5),
        "w_up_e": nrm(ks[27], (L, N_EXPERTS, D, D_EXPERT), D ** -0.5),
        "w_down_e": nrm(ks[28], (L, N_EXPERTS, D_EXPERT, D), BETA * D_EXPERT ** -0.5),
        "w_ple": nrm(ks[29], (L, PLE_DIM, D), BETA * PLE_DIM ** -0.5),
        "w_ple_gate": nrm(ks[30], (L, D, D), D ** -0.5),
        "b_ple_gate": nrm(ks[31], (L, D), 0.02),
        "ln2_g": 1.0 + nrm(ks[32], (L, D), 0.02),
        "ln2_b": nrm(ks[33], (L, D), 0.02),
    }


def reference(x, p, ln0_g, ln0_b, w_in, q_norm_g, k_norm_g, ssm_a_re, ssm_a_im, ssm_log_dt,
              ssm_b_re, ssm_b_im, ssm_c_re, ssm_c_im, ssm_d, w_glu, b_glu, attn_out_g, ssm_out_g,
              w_out, ln1_g, ln1_b, router_group_w, router_group_b, router_expert_w, router_expert_b,
              w_gate_e, w_up_e, w_down_e, w_ple, w_ple_gate, b_ple_gate, ln2_g, ln2_b):
    seq_len = x.shape[1]
    cos, sin = axial_rope_tables(seq_len, x.dtype)
    x = layer_norm(x, ln0_g, ln0_b)
    for i in range(DEPTH):
        m = hybrid_mixer(x, cos, sin, w_in[i], q_norm_g[i], k_norm_g[i],
                         ssm_a_re[i], ssm_a_im[i], ssm_log_dt[i], ssm_b_re[i], ssm_b_im[i],
                         ssm_c_re[i], ssm_c_im[i], ssm_d[i], w_glu[i], b_glu[i],
                         attn_out_g[i], ssm_out_g[i], w_out[i])
        x = layer_norm(ALPHA * x + m, ln1_g[i], ln1_b[i])
        f = hierarchical_moe(x, router_group_w[i], router_group_b[i], router_expert_w[i],
                             router_expert_b[i], w_gate_e[i], w_up_e[i], w_down_e[i])
        ple = (p[i] @ w_ple[i]) * jax.nn.sigmoid(x @ w_ple_gate[i] + b_ple_gate[i])
        x = layer_norm(ALPHA * x + f + ple, ln2_g[i], ln2_b[i])
    return x
```

```cpp
#include <hip/hip_runtime.h>
#include <cstdio>
#include <cstdint>
#include <cmath>

#ifndef MK_ONE_LAUNCH
#define MK_ONE_LAUNCH 1
#endif

#define LAS __attribute__((address_space(3)))
#define GAS __attribute__((address_space(1)))
typedef unsigned short bf16_t;
typedef short bf16x8 __attribute__((ext_vector_type(8)));
typedef short s16x4 __attribute__((ext_vector_type(4)));
typedef float f32x2 __attribute__((ext_vector_type(2)));
typedef float f32x4 __attribute__((ext_vector_type(4)));
typedef float f32x8 __attribute__((ext_vector_type(8)));
typedef float f32x16 __attribute__((ext_vector_type(16)));
typedef unsigned u32x2 __attribute__((ext_vector_type(2)));
typedef unsigned u32x4 __attribute__((ext_vector_type(4)));

constexpr int NL = 4, BATCH = 2, SEQ = 4096, T = BATCH * SEQ, DM = 2048;
constexpr int AW = 1024, KVW = 256, SW = 1024, DIN = 2560, NE = 16, DE = 512, PLE = 256;
constexpr int NG = 64, NP = 64, NH = 16, CH = 16, NCH = SEQ / CH;
constexpr float ALPHA = 1.6817928305074290f;
constexpr float EPS = 1e-6f;
constexpr int NWAVES = 8;

constexpr size_t MiB = 1u << 20;
constexpr size_t WS_CTL = 0, CTL_ZERO_BYTES = 1 * MiB;
constexpr size_t WS_TAB = 1 * MiB;
constexpr size_t WS_PB = 3 * MiB;
constexpr size_t WS_W = 19 * MiB;
constexpr size_t WL_IN = 0, WL_GLU = 10 * MiB, WL_OUT = 12 * MiB, WL_GU = 20 * MiB, WL_DN = 84 * MiB, WL_PLE = 116 * MiB, WL_PG = 117 * MiB,
                 WL_S1 = 125 * MiB, WL_S2 = 133 * MiB, WL_RT = 149 * MiB, WL_BYTES = 150 * MiB;
constexpr size_t WS_ACT = WS_W + NL * WL_BYTES;
constexpr size_t WS_XF = WS_ACT, WS_XB = WS_XF + 64 * MiB, WS_Q = WS_XB + 32 * MiB, WS_K = WS_Q + 16 * MiB, WS_V = WS_K + 4 * MiB,
                 WS_UX = WS_V + 4 * MiB, WS_SS = WS_UX + 32 * MiB, WS_CAT = WS_SS + 32 * MiB, WS_Y = WS_CAT + 32 * MiB, WS_SSQ = WS_Y + 16 * MiB,
                 WS_PL = WS_SSQ + 1 * MiB, WS_HID = WS_PL + 32 * MiB, WS_FP = WS_HID + 20 * MiB, WS_LT = WS_FP + 64 * MiB, WS_LG = WS_LT + 2 * MiB,
                 WS_END = WS_LG + 2 * MiB;
constexpr int CW_TMO = 0, CW_CODE = 1, CW_BAR = 4096, CW_CNT = 16384;

constexpr int RING_BYTES = 131072;
constexpr int LX_P = RING_BYTES;
constexpr int LX_INFO = RING_BYTES + 8192;
constexpr int LX_MISC = RING_BYTES + 8192 + 512;
constexpr int LDS_BYTES = 147456;

#define RLX_AGENT __ATOMIC_RELAXED, __HIP_MEMORY_SCOPE_AGENT
#define LDS_WAIT() asm volatile("s_waitcnt lgkmcnt(0)" ::: "memory")
#define VM_WAIT() asm volatile("s_waitcnt vmcnt(0)" ::: "memory")
__device__ __forceinline__ unsigned cvt_pk_bf16(float lo, float hi) { unsigned r; asm volatile("v_cvt_pk_bf16_f32 %0, %1, %2" : "=v"(r) : "v"(lo), "v"(hi)); return r; }
__device__ __forceinline__ float bf_lo(unsigned w) { return __uint_as_float(w << 16); }
__device__ __forceinline__ float bf_hi(unsigned w) { return __uint_as_float(w & 0xffff0000u); }
__device__ __forceinline__ float dpp_f(float v, const int ctrl) { return v; }
#define DPP_ADD(v, ctrl) v += __builtin_bit_cast(float, __builtin_amdgcn_update_dpp(0, __builtin_bit_cast(int, v), ctrl, 0xF, 0xF, false))
__device__ __forceinline__ float row16_sum(float v) {
    DPP_ADD(v, 0xB1); DPP_ADD(v, 0x4E); DPP_ADD(v, 0x141); DPP_ADD(v, 0x140); return v;
}
__device__ __forceinline__ float wave_sum(float v) {
    v = row16_sum(v); const int b = __builtin_bit_cast(int, v);
    return (__builtin_bit_cast(float, __builtin_amdgcn_readlane(b, 0)) + __builtin_bit_cast(float, __builtin_amdgcn_readlane(b, 16))) +
           (__builtin_bit_cast(float, __builtin_amdgcn_readlane(b, 32)) + __builtin_bit_cast(float, __builtin_amdgcn_readlane(b, 48)));
}
__device__ __forceinline__ float sigmoidf_(float z) { return __builtin_amdgcn_rcpf(1.0f + __builtin_amdgcn_exp2f(-1.4426950408889634f * z)); }
__device__ __forceinline__ float gelu_tanh(float x) {
    const float u = 1.5957691216057308f * (x + 0.044715f * x * x * x);
    return x * sigmoidf_(u);
}

namespace pg8 {
constexpr int BM = 256, BK = 64, HALF = 128, HTB = HALF * BK * 2, STAGE_BYTES = 8 * HTB;
__host__ __device__ __forceinline__ int lds_byte(int r, int c) { const int st = (r >> 4) * 2 + (c >> 5), rr = r & 15, cc = c & 31, ob = rr * 64 + cc * 2; return st * 1024 + (ob ^ (((ob >> 9) & 1) << 5)); }
__host__ __device__ __forceinline__ void stage_rc(int b, int& R, int& C) { const int st = b / 1024, sb = b % 1024, swz = sb ^ (((sb >> 9) & 1) << 5); R = (st >> 1) * 16 + swz / 64; C = (st & 1) * 32 + (swz % 64) / 2; }
__host__ __device__ __forceinline__ int perm32(int rho) { const int n = rho >> 4, i = rho & 15; return 8 * (i >> 2) + 4 * n + (i & 3); }
__host__ __device__ __forceinline__ int brow_id(int R) { return R; }
__host__ __device__ __forceinline__ int brow_p8(int R) { return (R & ~31) + perm32(R & 31); }
__host__ __device__ __forceinline__ int brow_rope(int R) { return ((R >> 4) & 1) * 64 + (R >> 5) * 16 + (R & 15); }

struct Unit { const char* A; const char* B; int pm, pn, x0, x1, x2; unsigned a00, a01, a10, a11; };

template <class Epi, class Sched, bool ALIGN_EPI, bool HALF_M = false>
__device__ __forceinline__ void gemm_phase(LAS unsigned char* lds, const int K, const int lda, const Sched& S, const Epi& E) {
    int tid = threadIdx.x; asm volatile("" : "+v"(tid));
    const int wid = __builtin_amdgcn_readfirstlane(tid >> 6), lane = tid & 63, wr = wid >> 2, wc = wid & 3, fr = lane & 15, fq = lane >> 4;
    int nt = K / BK; asm volatile("" : "+s"(nt));
    unsigned voffA[2], voffB[2];
#pragma unroll
    for (int i = 0; i < 2; ++i) { int R, C; stage_rc(tid * 16 + i * 8192, R, C); const int Rb = Epi::brow(R);
        voffA[i] = (unsigned)(R * lda + C) * 2u; voffB[i] = (unsigned)(Rb * K + C) * 2u; }
    const size_t kstep = (size_t)(BK * 2);
    const size_t hstepA = (size_t)HALF * lda * 2, hstepB = (size_t)HALF * K * 2;
    const unsigned ldsw = (unsigned)wid * 1024u;
    const int aoff = lds_byte(wr * 64 + fr, fq * 8), boff = lds_byte(wc * 32 + fr, fq * 8);
#define PG8_SA(b, h) (((b) * 2 + (h)) * HTB)
#define PG8_SB(b, h) ((4 + (b) * 2 + (h)) * HTB)
#define PG8_GL(src, bufoff, i_) __builtin_amdgcn_global_load_lds((const unsigned*)(src), (LAS unsigned*)(lds + (bufoff) + ldsw + (i_) * 8192), 16, 0, 0)
#define PG8_STAGE_B(bufoff, gbase) do { PG8_GL((gbase) + voffB[0], bufoff, 0); PG8_GL((gbase) + voffB[1], bufoff, 1); } while (0)
#define PG8_STAGE_A(bufoff, gbase, h, o0, o1) do { if constexpr (Sched::GATHER) { PG8_GL((gbase) + (o0), bufoff, 0); PG8_GL((gbase) + (o1), bufoff, 1); } \
        else { PG8_GL((gbase) + (h) * hstepA + voffA[0], bufoff, 0); PG8_GL((gbase) + (h) * hstepA + voffA[1], bufoff, 1); } } while (0)
#define PG8_LDA(dst, b, h) do { _Pragma("unroll") for (int m = 0; m < 4; ++m) _Pragma("unroll") for (int k = 0; k < 2; ++k) dst[m][k] = *(const LAS bf16x8*)(lds + PG8_SA(b, h) + aoff + m * 2048 + k * 1024); } while (0)
#define PG8_LDB(dst, b, h) do { _Pragma("unroll") for (int n = 0; n < 2; ++n) _Pragma("unroll") for (int k = 0; k < 2; ++k) dst[n][k] = *(const LAS bf16x8*)(lds + PG8_SB(b, h) + boff + n * 2048 + k * 1024); } while (0)
#define PG8_MMA(ai, bj, At, Bt) do { __builtin_amdgcn_s_setprio(1); _Pragma("unroll") for (int m = 0; m < 4; ++m) _Pragma("unroll") for (int n = 0; n < 2; ++n) _Pragma("unroll") for (int k = 0; k < 2; ++k) \
        acc[ai][bj][m][n] = __builtin_amdgcn_mfma_f32_16x16x32_bf16(Bt[n][k], At[m][k], acc[ai][bj][m][n], 0, 0, 0); __builtin_amdgcn_s_setprio(0); } while (0)
#define PG8_WAIT_V(n) asm volatile("s_waitcnt vmcnt(" #n ")" ::: "memory")
#define PG8_WAIT_L(n) asm volatile("s_waitcnt lgkmcnt(" #n ")" ::: "memory")
#define PG8_BAR __builtin_amdgcn_s_barrier()
#define PG8_SCHED __builtin_amdgcn_sched_barrier(0)
    Unit cur, nxt; int ui = 0;
    if (!S.next(0, cur)) return;
    f32x4 acc[2][2][4][2];
#pragma unroll
    for (int a = 0; a < 2; ++a)
#pragma unroll
        for (int b = 0; b < 2; ++b)
#pragma unroll
            for (int m = 0; m < 4; ++m)
#pragma unroll
                for (int n = 0; n < 2; ++n) acc[a][b][m][n] = (f32x4){0.f, 0.f, 0.f, 0.f};
    bf16x8 At[4][2], B0[2][2], B1[2][2];
    const char* cA = cur.A; const char* cB = cur.B;
    PG8_STAGE_B(PG8_SB(0, 0), cB); PG8_STAGE_B(PG8_SB(0, 1), cB + hstepB); PG8_STAGE_A(PG8_SA(0, 0), cA, 0, cur.a00, cur.a01); if constexpr (!HALF_M) PG8_STAGE_A(PG8_SA(0, 1), cA, 1, cur.a10, cur.a11);
    if (wr == 1) PG8_BAR;
    if constexpr (HALF_M) PG8_WAIT_V(0); else PG8_WAIT_V(2);
    PG8_BAR;
    PG8_STAGE_B(PG8_SB(1, 0), cB + kstep); PG8_STAGE_A(PG8_SA(1, 0), cA + kstep, 0, cur.a00, cur.a01); PG8_STAGE_B(PG8_SB(1, 1), cB + hstepB + kstep);
    PG8_WAIT_V(6); PG8_BAR;
    for (;;) {
        const bool has_next = S.next(ui + 1, nxt);
        const char* nA = has_next ? nxt.A : cA; const char* nB = has_next ? nxt.B : cB;
        if (!has_next) { nxt.a00 = cur.a00; nxt.a01 = cur.a01; nxt.a10 = cur.a10; nxt.a11 = cur.a11; }
        for (int t = 0; t < nt; t += 2) {
            const bool last = (t == nt - 2);
            const char* a1 = cA + (size_t)(t + 1) * kstep;
            const char* a2 = last ? nA : cA + (size_t)(t + 2) * kstep; const char* b2 = last ? nB : cB + (size_t)(t + 2) * kstep;
            const char* a3 = a2 + kstep; const char* b3 = b2 + kstep;
            const unsigned s00 = last ? nxt.a00 : cur.a00, s01 = last ? nxt.a01 : cur.a01, s10 = last ? nxt.a10 : cur.a10, s11 = last ? nxt.a11 : cur.a11;
            if constexpr (Epi::MID) { if (t == (nt >> 1)) { int fr_ = fr; asm volatile("" : "+v"(fr_)); E.mid(acc, cur, wr, wc, fr_, fq); } }
            if constexpr (!HALF_M) {
            PG8_LDB(B0, 0, 0); PG8_LDB(B1, 0, 1); PG8_SCHED; PG8_LDA(At, 0, 0); PG8_STAGE_A(PG8_SA(1, 1), a1, 1, cur.a10, cur.a11);
            PG8_WAIT_V(8); PG8_WAIT_L(0); PG8_BAR; PG8_MMA(0, 0, At, B0); PG8_MMA(0, 1, At, B1); PG8_BAR; PG8_SCHED;
            PG8_LDA(At, 0, 1); PG8_STAGE_B(PG8_SB(0, 0), b2); PG8_STAGE_B(PG8_SB(0, 1), b2 + hstepB); PG8_STAGE_A(PG8_SA(0, 0), a2, 0, s00, s01);
            PG8_WAIT_V(8); PG8_WAIT_L(0); PG8_BAR; PG8_MMA(1, 0, At, B0); PG8_MMA(1, 1, At, B1); PG8_BAR; PG8_SCHED;
            PG8_LDB(B0, 1, 0); PG8_LDB(B1, 1, 1); PG8_SCHED; PG8_LDA(At, 1, 0); PG8_STAGE_A(PG8_SA(0, 1), a2, 1, s10, s11);
            PG8_WAIT_V(8); PG8_WAIT_L(0); PG8_BAR; PG8_MMA(0, 0, At, B0); PG8_MMA(0, 1, At, B1); PG8_BAR; PG8_SCHED;
            PG8_LDA(At, 1, 1); PG8_STAGE_B(PG8_SB(1, 0), b3); PG8_STAGE_B(PG8_SB(1, 1), b3 + hstepB); PG8_STAGE_A(PG8_SA(1, 0), a3, 0, s00, s01);
            PG8_WAIT_V(8); PG8_WAIT_L(0); PG8_BAR; PG8_MMA(1, 0, At, B0); PG8_MMA(1, 1, At, B1); PG8_BAR; PG8_SCHED;
            } else {
            PG8_LDB(B0, 0, 0); PG8_LDB(B1, 0, 1); PG8_SCHED; PG8_LDA(At, 0, 0);
            PG8_WAIT_V(6); PG8_WAIT_L(0); PG8_BAR; PG8_MMA(0, 0, At, B0); PG8_MMA(0, 1, At, B1); PG8_BAR; PG8_SCHED;
            PG8_STAGE_B(PG8_SB(0, 0), b2); PG8_STAGE_B(PG8_SB(0, 1), b2 + hstepB); PG8_STAGE_A(PG8_SA(0, 0), a2, 0, s00, s01);
            PG8_WAIT_V(6); PG8_WAIT_L(0); PG8_BAR; PG8_BAR; PG8_SCHED;
            PG8_LDB(B0, 1, 0); PG8_LDB(B1, 1, 1); PG8_SCHED; PG8_LDA(At, 1, 0);
            PG8_WAIT_V(6); PG8_WAIT_L(0); PG8_BAR; PG8_MMA(0, 0, At, B0); PG8_MMA(0, 1, At, B1); PG8_BAR; PG8_SCHED;
            PG8_STAGE_B(PG8_SB(1, 0), b3); PG8_STAGE_B(PG8_SB(1, 1), b3 + hstepB); PG8_STAGE_A(PG8_SA(1, 0), a3, 0, s00, s01);
            PG8_WAIT_V(6); PG8_WAIT_L(0); PG8_BAR; PG8_BAR; PG8_SCHED;
            }
        }
        if constexpr (ALIGN_EPI) { if (wr == 0) PG8_BAR; }
        { int fr_ = fr, fq_ = fq; asm volatile("" : "+v"(fr_), "+v"(fq_)); E(acc, cur, wr, wc, fr_, fq_); }
        if (!has_next) break;
#pragma unroll
        for (int a = 0; a < 2; ++a)
#pragma unroll
            for (int b = 0; b < 2; ++b)
#pragma unroll
                for (int m = 0; m < 4; ++m)
#pragma unroll
                    for (int n = 0; n < 2; ++n) acc[a][b][m][n] = (f32x4){0.f, 0.f, 0.f, 0.f};
        cur = nxt; cA = nA; cB = nB; ++ui;
        if constexpr (ALIGN_EPI) { if (wr == 1) PG8_BAR; }
    }
    PG8_WAIT_V(0);
    if constexpr (!ALIGN_EPI) { if (wr == 0) PG8_BAR; }
    PG8_BAR;
#undef PG8_SA
#undef PG8_SB
#undef PG8_GL
#undef PG8_STAGE_A
#undef PG8_STAGE_B
#undef PG8_LDA
#undef PG8_LDB
#undef PG8_MMA
#undef PG8_WAIT_V
#undef PG8_WAIT_L
#undef PG8_BAR
#undef PG8_SCHED
}

constexpr int NXCD = 8, WGM = 8;
struct TileSched {
    static constexpr bool GATHER = false;
    const char* A; const char* B; int nM, nN, G, c; size_t astep, bstep; bool dup = false; int first = 0, count = 1 << 30;
    __device__ __forceinline__ bool next(int i_, Unit& u) const {
        const int nwg = nM * nN; if (c < 0) return false;
        const int i = dup ? (i_ > 1 ? 99999 : 0) : i_;
        const long L0 = (long)i * G + c; if (L0 >= count) return false; const long L = L0 + first; if (L >= nwg) return false;
        int wgid = (int)L; { const int q = nwg / NXCD, r = nwg % NXCD, xcd = wgid % NXCD, off = wgid / NXCD; wgid = (xcd < r ? xcd * (q + 1) : r * (q + 1) + (xcd - r) * q) + off; }
        const int nig = WGM * nN, gid = wgid / nig, fm = gid * WGM, gsz = (nM - fm) < WGM ? (nM - fm) : WGM;
        u.pm = fm + ((wgid % nig) % gsz); u.pn = (wgid % nig) / gsz; u.x0 = u.x1 = u.x2 = 0; u.a00 = u.a01 = u.a10 = u.a11 = 0u;
        u.A = A + (size_t)u.pm * astep; u.B = B + (size_t)u.pn * bstep; return true;
    }
};
struct InProjSched {
    static constexpr bool GATHER = false;
    const char* A; const char* B; int part, c; size_t astep, bstep;
    __device__ __forceinline__ bool next(int i, Unit& u) const {
        if (i > 0 || c < 0 || c >= 256) return false; const int xcd = c >> 5, loc = c & 31; int half = 0;
        if (part == 0) { const int sl = loc >> 2; u.pm = 4 * xcd + (loc & 3); u.pn = sl < 6 ? 4 + sl : sl - 6; }
        else { if (loc >= 16) return false; u.pm = 4 * xcd + (loc & 3); half = (loc >> 2) & 1; u.pn = 2 + (loc >> 3); }
        u.x0 = u.x1 = 0; u.x2 = u.pm * 256 + half * 128; u.a00 = u.a01 = u.a10 = u.a11 = 0u; u.A = A + (size_t)u.pm * astep + (size_t)half * (astep >> 1); u.B = B + (size_t)u.pn * bstep; return true;
    }
};
struct PgSched {
    static constexpr bool GATHER = false;
    const char* A; const char* B; int j0, count, c; size_t astep, bstep;
    __device__ __forceinline__ bool next(int i, Unit& u) const {
        if (i > 0 || c < 0 || c >= count) return false; const int j = j0 + c;
        u.pm = j >> 3; u.pn = j & 7; u.x0 = u.x1 = u.x2 = 0; u.a00 = u.a01 = u.a10 = u.a11 = 0u; u.A = A + (size_t)u.pm * astep; u.B = B + (size_t)u.pn * bstep; return true;
    }
};
struct OneSched {
    static constexpr bool GATHER = false;
    const char* A; const char* B; int pm, pn; bool active;
    __device__ __forceinline__ bool next(int i, Unit& u) const {
        if (i > 0 || !active) return false;
        u.A = A; u.B = B; u.pm = pm; u.pn = pn; u.x0 = u.x1 = u.x2 = 0; u.a00 = u.a01 = u.a10 = u.a11 = 0u; return true;
    }
};
struct MoeGuSched {
    static constexpr bool GATHER = true;
    const LAS int* info; const char* XB; const char* W; const unsigned* ltok; int G, c; int R0, R1; unsigned c0, c1;
    __device__ __forceinline__ bool next(int i, Unit& u) const {
        const int idx = i * G + c, ntile = info[32]; if (idx >= 4 * ntile) return false;
        const int tile = idx >> 2, j = idx & 3; int e = 0;
#pragma unroll
        for (int k = 1; k < 16; ++k) if (tile >= info[16 + k]) e = k;
        const int tl = tile - info[16 + e], cnt = info[e];
        u.A = XB; u.B = W + ((size_t)e * 1024 + (size_t)j * 256) * (DM * 2); u.pm = tile; u.pn = j; u.x0 = e; u.x1 = tl * 256; u.x2 = cnt;
        const unsigned* lt = ltok + e * 8192 + tl * 256;
        const int p00 = R0, p01 = R1, p10 = 128 + R0, p11 = 128 + R1;
        const unsigned t00 = (tl * 256 + p00 < cnt) ? (lt[p00] & 0xffffu) : 0u, t01 = (tl * 256 + p01 < cnt) ? (lt[p01] & 0xffffu) : 0u;
        const unsigned t10 = (tl * 256 + p10 < cnt) ? (lt[p10] & 0xffffu) : 0u, t11 = (tl * 256 + p11 < cnt) ? (lt[p11] & 0xffffu) : 0u;
        u.a00 = t00 * (DM * 2) + c0; u.a01 = t01 * (DM * 2) + c1; u.a10 = t10 * (DM * 2) + c0; u.a11 = t11 * (DM * 2) + c1; return true;
    }
};
struct MoeDnSched {
    static constexpr bool GATHER = false;
    const LAS int* info; const char* HID; const char* W; int G, c;
    __device__ __forceinline__ bool next(int i, Unit& u) const {
        const int idx = i * G + c, ntile = info[32]; if (c < 0 || idx >= 8 * ntile) return false;
        const int tile = idx >> 3, j = idx & 7; int e = 0;
#pragma unroll
        for (int k = 1; k < 16; ++k) if (tile >= info[16 + k]) e = k;
        const int tl = tile - info[16 + e];
        u.A = HID + (size_t)tile * 256 * (DE * 2); u.B = W + ((size_t)e * DM + (size_t)j * 256) * (DE * 2); u.pm = tile; u.pn = j; u.x0 = e; u.x1 = tl * 256; u.x2 = info[e];
        u.a00 = u.a01 = u.a10 = u.a11 = 0u; return true;
    }
};

typedef const f32x4 (&AccRef)[2][2][4][2];
template <int NAI> struct EpiInProj {
    static constexpr bool MID = false; static __host__ __device__ int brow(int R) { return brow_rope(R); }
    bf16_t *Q, *Kb, *Vb, *UX; const float *gq, *gk, *cosT, *sinT; LAS float* P;
    __device__ __forceinline__ void operator()(AccRef acc, const Unit& u, int wr, int wc, int fr, int fq) const {
        const int rl0 = wr * 64 + fr, dlo = 16 * wc + 4 * fq;
        if (u.pn <= 4) {
#pragma unroll
            for (int ai = 0; ai < NAI; ++ai)
#pragma unroll
                for (int m = 0; m < 4; ++m)
#pragma unroll
                    for (int bj = 0; bj < 2; ++bj) {
                        const f32x4 a = acc[ai][bj][m][0], b = acc[ai][bj][m][1];
                        float s = (a[0] * a[0] + a[1] * a[1]) + (a[2] * a[2] + a[3] * a[3]) + (b[0] * b[0] + b[1] * b[1]) + (b[2] * b[2] + b[3] * b[3]);
                        s += __shfl_xor(s, 16); s += __shfl_xor(s, 32);
                        if (fq == 0) P[((ai * 128 + m * 16 + rl0) * 2 + bj) * 4 + wc] = s;
                    }
            asm volatile("s_waitcnt lgkmcnt(0)" ::: "memory"); __builtin_amdgcn_s_barrier(); asm volatile("" ::: "memory");
            const float* g = (u.pn < 4) ? gq : gk;
            const f32x4 glo = *(const f32x4*)(g + dlo), ghi = *(const f32x4*)(g + 64 + dlo);
#pragma unroll
            for (int ai = 0; ai < NAI; ++ai)
#pragma unroll
                for (int m = 0; m < 4; ++m) {
                    const int rl = ai * 128 + m * 16 + rl0, row = u.x2 + rl, t = row & (SEQ - 1);
                    const f32x4 cs = *(const f32x4*)(cosT + t * 64 + dlo), sn = *(const f32x4*)(sinT + t * 64 + dlo);
#pragma unroll
                    for (int bj = 0; bj < 2; ++bj) {
                        const f32x4 pv = *(const LAS f32x4*)(P + (rl * 2 + bj) * 4);
                        const float rstd = rsqrtf(((pv[0] + pv[1]) + (pv[2] + pv[3])) * (1.0f / 128.0f) + EPS);
                        const f32x4 lo = acc[ai][bj][m][0] * rstd * glo, hi = acc[ai][bj][m][1] * rstd * ghi;
                        const f32x4 olo = lo * cs - hi * sn, ohi = hi * cs + lo * sn;
                        bf16_t* dst = (u.pn < 4) ? Q + (size_t)row * AW + (2 * u.pn + bj) * 128 + dlo : Kb + (size_t)row * KVW + bj * 128 + dlo;
                        u32x2 w0, w1; w0.x = cvt_pk_bf16(olo[0], olo[1]); w0.y = cvt_pk_bf16(olo[2], olo[3]); w1.x = cvt_pk_bf16(ohi[0], ohi[1]); w1.y = cvt_pk_bf16(ohi[2], ohi[3]);
                        *(u32x2*)dst = w0; *(u32x2*)(dst + 64) = w1;
                    }
                }
        } else if (u.pn == 5) {
#pragma unroll
            for (int ai = 0; ai < NAI; ++ai)
#pragma unroll
                for (int m = 0; m < 4; ++m) {
                    const int row = u.x2 + ai * 128 + m * 16 + rl0;
#pragma unroll
                    for (int bj = 0; bj < 2; ++bj)
#pragma unroll
                        for (int n = 0; n < 2; ++n) { const f32x4 v = acc[ai][bj][m][n]; u32x2 w; w.x = cvt_pk_bf16(v[0], v[1]); w.y = cvt_pk_bf16(v[2], v[3]);
                            *(u32x2*)(Vb + (size_t)row * KVW + bj * 128 + n * 64 + dlo) = w; }
                }
        } else {
#pragma unroll
            for (int ai = 0; ai < NAI; ++ai)
#pragma unroll
                for (int m = 0; m < 4; ++m) {
                    const int row = u.x2 + ai * 128 + m * 16 + rl0, b = row >> 12, t = row & (SEQ - 1), c = t >> 4, sg = t & 15;
#pragma unroll
                    for (int bj = 0; bj < 2; ++bj)
#pragma unroll
                        for (int n = 0; n < 2; ++n) { const f32x4 v = acc[ai][bj][m][n]; u32x2 w; w.x = cvt_pk_bf16(v[0], v[1]); w.y = cvt_pk_bf16(v[2], v[3]);
                            const int g = (u.pn - 6) * 16 + bj * 8 + n * 4 + wc;
                            *(u32x2*)(UX + ((size_t)((b * NG + g) * NCH + c)) * 512 + sg * 16 + 4 * fq) = w; }
                }
        }
    }
};
struct EpiS1 {
    static constexpr bool MID = false; static __host__ __device__ int brow(int R) { return brow_id(R); }
    float* S;
    __device__ __forceinline__ void operator()(AccRef acc, const Unit& u, int wr, int wc, int fr, int fq) const {
#pragma unroll
        for (int ai = 0; ai < 2; ++ai)
#pragma unroll
            for (int m = 0; m < 4; ++m) { float* rp = S + (size_t)(ai * 128 + wr * 64 + m * 16 + fr) * 256 + wc * 32 + 4 * fq;
#pragma unroll
                for (int bj = 0; bj < 2; ++bj)
#pragma unroll
                    for (int n = 0; n < 2; ++n) *(f32x4*)(rp + bj * 128 + n * 16) = acc[ai][bj][m][n]; }
    }
};
struct EpiS2 {
    static constexpr bool MID = false; static __host__ __device__ int brow(int R) { return brow_id(R); }
    bf16_t* Y;
    __device__ __forceinline__ void operator()(AccRef acc, const Unit& u, int wr, int wc, int fr, int fq) const {
        const int b = u.pm, g = u.pn;
#pragma unroll
        for (int ai = 0; ai < 2; ++ai)
#pragma unroll
            for (int m = 0; m < 4; ++m) { const int c = ai * 128 + wr * 64 + m * 16 + fr;
#pragma unroll
                for (int bj = 0; bj < 2; ++bj)
#pragma unroll
                    for (int n = 0; n < 2; ++n) { const f32x4 v = acc[ai][bj][m][n]; const int tau = bj * 8 + wc * 2 + n; u32x2 w;
                        w.x = cvt_pk_bf16(gelu_tanh(v[0]), gelu_tanh(v[1])); w.y = cvt_pk_bf16(gelu_tanh(v[2]), gelu_tanh(v[3]));
                        *(u32x2*)(Y + (size_t)(b * SEQ + c * 16 + tau) * SW + g * 16 + 4 * fq) = w; } }
    }
};
struct EpiGlu {
    static constexpr bool MID = false; static __host__ __device__ int brow(int R) { return brow_p8(R); }
    const bf16_t* Y; const float* bias; bf16_t* CAT; float* SSQS;
    __device__ __forceinline__ void operator()(AccRef acc, const Unit& u, int wr, int wc, int fr, int fq) const {
        const int colw = u.pn * 256 + wc * 32 + 8 * fq;
        f32x4 bv[2][2];
#pragma unroll
        for (int bj = 0; bj < 2; ++bj)
#pragma unroll
            for (int n = 0; n < 2; ++n) bv[bj][n] = *(const f32x4*)(bias + colw + bj * 128 + 4 * n);
#pragma unroll
        for (int ai = 0; ai < 2; ++ai)
#pragma unroll
            for (int m = 0; m < 4; ++m) { const int row = u.pm * 256 + ai * 128 + wr * 64 + m * 16 + fr; float ss = 0.f;
#pragma unroll
                for (int bj = 0; bj < 2; ++bj) { const int col = colw + bj * 128; const u32x4 yw = *(const u32x4*)(Y + (size_t)row * SW + col);
                    const f32x4 z0 = acc[ai][bj][m][0] + bv[bj][0], z1 = acc[ai][bj][m][1] + bv[bj][1];
                    float o[8];
                    o[0] = bf_lo(yw.x) * sigmoidf_(z0[0]); o[1] = bf_hi(yw.x) * sigmoidf_(z0[1]); o[2] = bf_lo(yw.y) * sigmoidf_(z0[2]); o[3] = bf_hi(yw.y) * sigmoidf_(z0[3]);
                    o[4] = bf_lo(yw.z) * sigmoidf_(z1[0]); o[5] = bf_hi(yw.z) * sigmoidf_(z1[1]); o[6] = bf_lo(yw.w) * sigmoidf_(z1[2]); o[7] = bf_hi(yw.w) * sigmoidf_(z1[3]);
#pragma unroll
                    for (int k = 0; k < 8; ++k) ss += o[k] * o[k];
                    u32x4 w; w.x = cvt_pk_bf16(o[0], o[1]); w.y = cvt_pk_bf16(o[2], o[3]); w.z = cvt_pk_bf16(o[4], o[5]); w.w = cvt_pk_bf16(o[6], o[7]);
                    *(u32x4*)(CAT + (size_t)row * DM + AW + col) = w; }
                ss += __shfl_xor(ss, 16); ss += __shfl_xor(ss, 32);
                if (fq == 0) SSQS[(size_t)row * 16 + u.pn * 4 + wc] = ss; }
    }
};
struct EpiBf16P8 {
    static constexpr bool MID = false; static __host__ __device__ int brow(int R) { return brow_p8(R); }
    bf16_t* O; int ldc;
    __device__ __forceinline__ void operator()(AccRef acc, const Unit& u, int wr, int wc, int fr, int fq) const {
        const int colw = u.pn * 256 + wc * 32 + 8 * fq;
#pragma unroll
        for (int ai = 0; ai < 2; ++ai)
#pragma unroll
            for (int m = 0; m < 4; ++m) { bf16_t* rp = O + (size_t)(u.pm * 256 + ai * 128 + wr * 64 + m * 16 + fr) * ldc + colw;
#pragma unroll
                for (int bj = 0; bj < 2; ++bj) { const f32x4 v0 = acc[ai][bj][m][0], v1 = acc[ai][bj][m][1]; u32x4 w;
                    w.x = cvt_pk_bf16(v0[0], v0[1]); w.y = cvt_pk_bf16(v0[2], v0[3]); w.z = cvt_pk_bf16(v1[0], v1[1]); w.w = cvt_pk_bf16(v1[2], v1[3]);
                    *(u32x4*)(rp + bj * 128) = w; } }
    }
};
struct EpiOut {
    static constexpr bool MID = true; static __host__ __device__ int brow(int R) { return brow_p8(R); }
    bf16_t* M; const LAS f32x2* st;
    __device__ __forceinline__ void mid(f32x4 (&acc)[2][2][4][2], const Unit& u, int wr, int wc, int fr, int fq) const {
#pragma unroll
        for (int ai = 0; ai < 2; ++ai)
#pragma unroll
            for (int m = 0; m < 4; ++m) { const float r = st[ai * 128 + wr * 64 + m * 16 + fr].x;
#pragma unroll
                for (int bj = 0; bj < 2; ++bj)
#pragma unroll
                    for (int n = 0; n < 2; ++n) acc[ai][bj][m][n] *= r; }
    }
    __device__ __forceinline__ void operator()(AccRef acc, const Unit& u, int wr, int wc, int fr, int fq) const {
        const int colw = u.pn * 256 + wc * 32 + 8 * fq;
#pragma unroll
        for (int ai = 0; ai < 2; ++ai)
#pragma unroll
            for (int m = 0; m < 4; ++m) { const int rl = ai * 128 + wr * 64 + m * 16 + fr; const float rs = st[rl].y;
                bf16_t* rp = M + (size_t)(u.pm * 256 + rl) * DM + colw;
#pragma unroll
                for (int bj = 0; bj < 2; ++bj) { const f32x4 v0 = acc[ai][bj][m][0] * rs, v1 = acc[ai][bj][m][1] * rs; u32x4 w;
                    w.x = cvt_pk_bf16(v0[0], v0[1]); w.y = cvt_pk_bf16(v0[2], v0[3]); w.z = cvt_pk_bf16(v1[0], v1[1]); w.w = cvt_pk_bf16(v1[2], v1[3]);
                    *(u32x4*)(rp + bj * 128) = w; } }
    }
};
struct EpiGu {
    static constexpr bool MID = false; static __host__ __device__ int brow(int R) { return brow_p8(R); }
    bf16_t* HID;
    __device__ __forceinline__ void operator()(AccRef acc, const Unit& u, int wr, int wc, int fr, int fq) const {
#pragma unroll
        for (int ai = 0; ai < 2; ++ai)
#pragma unroll
            for (int m = 0; m < 4; ++m) { const int rl = ai * 128 + wr * 64 + m * 16 + fr; float o[8];
#pragma unroll
                for (int n = 0; n < 2; ++n)
#pragma unroll
                    for (int j = 0; j < 4; ++j) { const float g = acc[ai][0][m][n][j], up = acc[ai][1][m][n][j]; o[n * 4 + j] = g * sigmoidf_(g) * up; }
                u32x4 w; w.x = cvt_pk_bf16(o[0], o[1]); w.y = cvt_pk_bf16(o[2], o[3]); w.z = cvt_pk_bf16(o[4], o[5]); w.w = cvt_pk_bf16(o[6], o[7]);
                *(u32x4*)(HID + ((size_t)u.pm * 256 + rl) * DE + u.pn * 128 + wc * 32 + 8 * fq) = w; }
    }
};
struct EpiPg {
    static constexpr bool MID = false; static __host__ __device__ int brow(int R) { return brow_p8(R); }
    const float* bias; const bf16_t* PL; bf16_t* PO;
    __device__ __forceinline__ void operator()(AccRef acc, const Unit& u, int wr, int wc, int fr, int fq) const {
        const int colw = u.pn * 256 + wc * 32 + 8 * fq;
        f32x4 bv[2][2];
#pragma unroll
        for (int bj = 0; bj < 2; ++bj)
#pragma unroll
            for (int n = 0; n < 2; ++n) bv[bj][n] = *(const f32x4*)(bias + colw + bj * 128 + 4 * n);
#pragma unroll
        for (int ai = 0; ai < 2; ++ai)
#pragma unroll
            for (int m = 0; m < 4; ++m) { const size_t ro = (size_t)(u.pm * 256 + ai * 128 + wr * 64 + m * 16 + fr) * DM + colw;
#pragma unroll
                for (int bj = 0; bj < 2; ++bj) { const u32x4 pw = *(const u32x4*)(PL + ro + bj * 128); const f32x4 z0 = acc[ai][bj][m][0] + bv[bj][0], z1 = acc[ai][bj][m][1] + bv[bj][1]; u32x4 w;
                    w.x = cvt_pk_bf16(sigmoidf_(z0[0]) * bf_lo(pw.x), sigmoidf_(z0[1]) * bf_hi(pw.x)); w.y = cvt_pk_bf16(sigmoidf_(z0[2]) * bf_lo(pw.y), sigmoidf_(z0[3]) * bf_hi(pw.y));
                    w.z = cvt_pk_bf16(sigmoidf_(z1[0]) * bf_lo(pw.z), sigmoidf_(z1[1]) * bf_hi(pw.z)); w.w = cvt_pk_bf16(sigmoidf_(z1[2]) * bf_lo(pw.w), sigmoidf_(z1[3]) * bf_hi(pw.w));
                    *(u32x4*)(PO + ro + bj * 128) = w; } }
    }
};
struct EpiDown {
    static constexpr bool MID = false; static __host__ __device__ int brow(int R) { return brow_p8(R); }
    bf16_t* FP; const unsigned* ltok; const float* lgate;
    __device__ __forceinline__ void operator()(AccRef acc, const Unit& u, int wr, int wc, int fr, int fq) const {
        const int colw = u.pn * 256 + wc * 32 + 8 * fq;
#pragma unroll
        for (int ai = 0; ai < 2; ++ai)
#pragma unroll
            for (int m = 0; m < 4; ++m) { const int pos = u.x1 + ai * 128 + wr * 64 + m * 16 + fr;
                if (pos < u.x2) { const unsigned ent = ltok[u.x0 * 8192 + pos]; const float gt = lgate[u.x0 * 8192 + pos];
                    bf16_t* rp = FP + ((size_t)(ent & 0xffffu) * 2 + (ent >> 16)) * DM + colw;
#pragma unroll
                    for (int bj = 0; bj < 2; ++bj) { const f32x4 v0 = acc[ai][bj][m][0] * gt, v1 = acc[ai][bj][m][1] * gt; u32x4 w;
                        w.x = cvt_pk_bf16(v0[0], v0[1]); w.y = cvt_pk_bf16(v0[2], v0[3]); w.z = cvt_pk_bf16(v1[0], v1[1]); w.w = cvt_pk_bf16(v1[2], v1[3]);
                        *(u32x4*)(rp + bj * 128) = w; } } }
    }
};
}

namespace att {
constexpr int D = 128, NW = 8, QBLK = 32, KVBLK = 64;
constexpr float SCALE = 0.088388347648318440f;
constexpr float THR = 8.f;
constexpr int LDQ = AW, LDK = KVW, LDO = DM;
constexpr size_t SHM_V = KVBLK * D * 2, SHM_K = KVBLK * D * 2, SHM_ATTN = 2 * SHM_V + 2 * SHM_K + NW * 64 * 4;
#define KSWZ(row, colB) ((row) * 256 + ((colB) ^ (((row) & 7) << 4)))
#define SBAR() __builtin_amdgcn_sched_barrier(0)
__device__ __forceinline__ int crow(int r, int hi) { return (r & 3) + 8 * (r >> 2) + 4 * hi; }
__device__ __forceinline__ unsigned cvtpk(float lo, float hi) { unsigned r; asm volatile("v_cvt_pk_bf16_f32 %0, %1, %2" : "=v"(r) : "v"(lo), "v"(hi)); return r; }
__device__ __forceinline__ void partialSM(f32x16& p0, f32x16& p1, float& m_reg, float& mn, float& alpha) {
  constexpr float C = SCALE * 1.4426950408889634f;
  float pmax = p0[0]; for (int r = 1; r < 16; ++r) pmax = fmaxf(pmax, p0[r]); for (int r = 0; r < 16; ++r) pmax = fmaxf(pmax, p1[r]);
  { auto rr = __builtin_amdgcn_permlane32_swap(__float_as_uint(pmax), __float_as_uint(pmax), false, false);
    pmax = fmaxf(__uint_as_float(rr[0]), __uint_as_float(rr[1])); }
  if (__builtin_expect(__all(pmax - m_reg <= THR / SCALE), 1)) { mn = m_reg; alpha = 1.f; }
  else { mn = fmaxf(m_reg, pmax); alpha = __builtin_amdgcn_exp2f((m_reg - mn) * C); m_reg = mn; }
  float mnC = -mn * C;
  for (int r = 0; r < 16; ++r) p0[r] = fmaf(p0[r], C, mnC); for (int r = 0; r < 16; ++r) p1[r] = fmaf(p1[r], C, mnC);
  for (int r = 0; r < 16; ++r) p0[r] = __builtin_amdgcn_exp2f(p0[r]);
}
__device__ __forceinline__ void finishSM(f32x16& p0, f32x16& p1, float alpha, float& l_reg, bf16x8& pa0, bf16x8& pa1, bf16x8& pa2, bf16x8& pa3) {
  for (int r = 0; r < 16; ++r) p1[r] = __builtin_amdgcn_exp2f(p1[r]);
  float ps = 0; for (int r = 0; r < 16; ++r) ps += p0[r]; for (int r = 0; r < 16; ++r) ps += p1[r];
  { auto rr = __builtin_amdgcn_permlane32_swap(__float_as_uint(ps), __float_as_uint(ps), false, false);
    ps = __uint_as_float(rr[0]) + __uint_as_float(rr[1]); }
  l_reg = l_reg * alpha + ps;
#define PK4(P, BASE, OUT) do { unsigned a0 = cvtpk(P[BASE + 0], P[BASE + 1]), a1 = cvtpk(P[BASE + 2], P[BASE + 3]);   \
    unsigned b0 = cvtpk(P[BASE + 4], P[BASE + 5]), b1 = cvtpk(P[BASE + 6], P[BASE + 7]);                              \
    auto r0 = __builtin_amdgcn_permlane32_swap(a0, b0, false, false); auto r1 = __builtin_amdgcn_permlane32_swap(a1, b1, false, false); \
    u32x4 w = {r0[0], r1[0], r0[1], r1[1]}; OUT = *reinterpret_cast<bf16x8*>(&w); } while (0)
  PK4(p0, 0, pa0); PK4(p0, 8, pa1); PK4(p1, 0, pa2); PK4(p1, 8, pa3);
#undef PK4
}
__device__ __forceinline__ void qkt(f32x16& p0, f32x16& p1, const bf16_t* Ks, const bf16x8* qr, int r32, int hi) {
  p0 = f32x16{}; p1 = f32x16{};
  for (int d0 = 0; d0 < 8; ++d0) { int cb = (d0 * 16 + hi * 8) * 2;
    bf16x8 b0 = *reinterpret_cast<const bf16x8*>((const char*)Ks + KSWZ(r32, cb));
    bf16x8 b1 = *reinterpret_cast<const bf16x8*>((const char*)Ks + KSWZ(32 + r32, cb));
    p0 = __builtin_amdgcn_mfma_f32_32x32x16_bf16(b0, qr[d0], p0, 0, 0, 0);
    p1 = __builtin_amdgcn_mfma_f32_32x32x16_bf16(b1, qr[d0], p1, 0, 0, 0); }
}
__device__ __forceinline__ int v_st(int k, int c) { const int kk = (k & ~0xC) | ((k & 4) << 1) | ((k & 8) >> 1); return ((kk >> 3) * 4 + (c >> 5)) * 512 + ((kk & 7) * 32 + (c & 31)) * 2; }
__device__ __forceinline__ int v_rd_base(int lane) { return ((lane & 3) << 3) | (((lane >> 2) & 3) << 6) | (((lane >> 4) & 1) << 5) | (((lane >> 5) & 1) << 8); }
constexpr int v_rd_off(int d0, int ks, int half) { return d0 * 512 + ks * 4096 + half * 2048; }
template <int OFF> __device__ __forceinline__ s16x4 tr_read(int vb) {
  s16x4 r; asm volatile("ds_read_b64_tr_b16 %0, %1 offset:%2" : "=&v"(r) : "v"(vb), "i"(OFF) : "memory"); return r;
}
template <int D0> __device__ __forceinline__ void pv_one(f32x16& od, int vb, bf16x8 pa0, bf16x8 pa1, bf16x8 pa2, bf16x8 pa3) {
  const s16x4 l0 = tr_read<v_rd_off(D0, 0, 0)>(vb), h0 = tr_read<v_rd_off(D0, 0, 1)>(vb), l1 = tr_read<v_rd_off(D0, 1, 0)>(vb), h1 = tr_read<v_rd_off(D0, 1, 1)>(vb);
  const s16x4 l2 = tr_read<v_rd_off(D0, 2, 0)>(vb), h2 = tr_read<v_rd_off(D0, 2, 1)>(vb), l3 = tr_read<v_rd_off(D0, 3, 0)>(vb), h3 = tr_read<v_rd_off(D0, 3, 1)>(vb);
  asm volatile("s_waitcnt lgkmcnt(0)" ::: "memory"); SBAR();
#define PK(L, H) (bf16x8){L[0], L[1], L[2], L[3], H[0], H[1], H[2], H[3]}
  od = __builtin_amdgcn_mfma_f32_32x32x16_bf16(pa0, PK(l0, h0), od, 0, 0, 0);
  od = __builtin_amdgcn_mfma_f32_32x32x16_bf16(pa1, PK(l1, h1), od, 0, 0, 0);
  od = __builtin_amdgcn_mfma_f32_32x32x16_bf16(pa2, PK(l2, h2), od, 0, 0, 0);
  od = __builtin_amdgcn_mfma_f32_32x32x16_bf16(pa3, PK(l3, h3), od, 0, 0, 0);
#undef PK
}
__device__ __forceinline__ void pv_d0(f32x16* o, int vb, bf16x8 pa0, bf16x8 pa1, bf16x8 pa2, bf16x8 pa3) {
  pv_one<0>(o[0], vb, pa0, pa1, pa2, pa3); pv_one<1>(o[1], vb, pa0, pa1, pa2, pa3); pv_one<2>(o[2], vb, pa0, pa1, pa2, pa3); pv_one<3>(o[3], vb, pa0, pa1, pa2, pa3);
}
__device__ __forceinline__ void attn_dense_body(const bf16_t* __restrict__ Qb, const bf16_t* __restrict__ Kh, const bf16_t* __restrict__ Vh,
                                                bf16_t* __restrict__ Ob, float* __restrict__ ssq, int seq, char* lds) {
  int tid = threadIdx.x; asm volatile("" : "+v"(tid));
  const int wid = tid >> 6, lane = tid & 63, r32 = lane & 31, hi = lane >> 5;
  bf16_t* V_lds = (bf16_t*)lds; bf16_t* K_lds = (bf16_t*)(lds + 2 * SHM_V);
  float* ws = (float*)(lds + 2 * SHM_V + 2 * SHM_K) + wid * 64; float* li_l = ws; float* al_l = ws + 32;
  float m_reg = -1e30f, l_reg = 0; f32x16 o[4] = {}; bf16x8 qr[8];
  const bf16_t* Qw = Qb + (long)(wid * QBLK + r32) * LDQ + hi * 8;
#pragma unroll
  for (int d0 = 0; d0 < 8; ++d0) qr[d0] = *reinterpret_cast<const bf16x8*>(Qw + d0 * 16);
  const int sr = tid >> 4, sc = (tid & 15) * 8, vst0 = v_st(sr, sc), vst1 = v_st(32 + sr, sc);
  const int vb0 = (int)(uintptr_t)V_lds + v_rd_base(lane);
  struct { bf16x8 vs0, vs1, ks0, ks1; } sr_[2];
#define SLOAD(i, k0) do { sr_[i].vs0 = *reinterpret_cast<const bf16x8*>(&Vh[(long)((k0) + sr) * LDK + sc]); sr_[i].vs1 = *reinterpret_cast<const bf16x8*>(&Vh[(long)((k0) + 32 + sr) * LDK + sc]); \
    sr_[i].ks0 = *reinterpret_cast<const bf16x8*>(&Kh[(long)((k0) + sr) * LDK + sc]); sr_[i].ks1 = *reinterpret_cast<const bf16x8*>(&Kh[(long)((k0) + 32 + sr) * LDK + sc]); } while (0)
#define SWRITE(b, i) do { *(bf16x8*)((char*)V_lds + (b) * SHM_V + vst0) = sr_[i].vs0;          \
    *(bf16x8*)((char*)V_lds + (b) * SHM_V + vst1) = sr_[i].vs1; int kc = sc * 2;               \
    *(bf16x8*)((char*)K_lds + (b) * SHM_K + KSWZ(sr, kc)) = sr_[i].ks0;                       \
    *(bf16x8*)((char*)K_lds + (b) * SHM_K + KSWZ(32 + sr, kc)) = sr_[i].ks1; } while (0)
#define SWAIT() asm volatile("s_waitcnt vmcnt(4)" ::: "memory")
#define RESC(a) do { if (__any((a) < 1.f)) { if (hi == 0) al_l[r32] = (a); asm volatile("s_waitcnt lgkmcnt(0)" ::: "memory"); \
    for (int d = 0; d < 4; ++d) for (int r = 0; r < 16; ++r) o[d][r] *= al_l[crow(r, hi)]; } } while (0)
  f32x16 pA0, pA1, pB0, pB1; float mnA, mnB, alA, alB; bf16x8 pa0, pa1, pa2, pa3; const int NT = seq / KVBLK;
  constexpr int SE = 0, SO = 1;
  SLOAD(SE, 0); asm volatile("s_waitcnt vmcnt(0)" ::: "memory"); SWRITE(0, SE); __syncthreads();
  qkt(pA0, pA1, K_lds, qr, r32, hi); partialSM(pA0, pA1, m_reg, mnA, alA);
  SLOAD(SO, KVBLK); if (2 < NT) SLOAD(SE, 2 * KVBLK);
  SWAIT(); SWRITE(1, SO); __syncthreads();
  for (int j = 1; j + 1 < NT; j += 2) {
    SBAR(); qkt(pB0, pB1, (bf16_t*)((char*)K_lds + SHM_K), qr, r32, hi);
    finishSM(pA0, pA1, alA, l_reg, pa0, pa1, pa2, pa3); SBAR();
    SLOAD(SO, (j + 2) * KVBLK); SBAR();
    pv_d0(o, vb0, pa0, pa1, pa2, pa3); partialSM(pB0, pB1, m_reg, mnB, alB);
    __syncthreads(); SWAIT(); SWRITE(0, SE);
    RESC(alB); __syncthreads();
    SBAR(); qkt(pA0, pA1, K_lds, qr, r32, hi);
    finishSM(pB0, pB1, alB, l_reg, pa0, pa1, pa2, pa3); SBAR();
    if (j + 3 < NT) SLOAD(SE, (j + 3) * KVBLK); SBAR();
    pv_d0(o, vb0 + (int)SHM_V, pa0, pa1, pa2, pa3); partialSM(pA0, pA1, m_reg, mnA, alA);
    __syncthreads(); SWAIT(); SWRITE(1, SO);
    RESC(alA); __syncthreads();
  }
  SBAR(); qkt(pB0, pB1, (bf16_t*)((char*)K_lds + SHM_K), qr, r32, hi);
  finishSM(pA0, pA1, alA, l_reg, pa0, pa1, pa2, pa3); SBAR();
  pv_d0(o, vb0, pa0, pa1, pa2, pa3); partialSM(pB0, pB1, m_reg, mnB, alB);
  __syncthreads(); RESC(alB);
  finishSM(pB0, pB1, alB, l_reg, pa0, pa1, pa2, pa3); SBAR();
  pv_d0(o, vb0 + (int)SHM_V, pa0, pa1, pa2, pa3);
  if (hi == 0) li_l[r32] = l_reg; asm volatile("s_waitcnt lgkmcnt(0)" ::: "memory");
  float rli[16];
#pragma unroll
  for (int r = 0; r < 16; ++r) rli[r] = __builtin_amdgcn_rcpf(li_l[crow(r, hi)]);
  int r32e = r32, hie = hi; asm volatile("" : "+v"(r32e), "+v"(hie));
  bf16_t* Ow = Ob + (long)(wid * QBLK) * LDO;
#pragma unroll
  for (int r = 0; r < 16; ++r) { const int orow = crow(r, hie); float ss = 0.f;
#pragma unroll
    for (int d0 = 0; d0 < 4; ++d0) { const float v = o[d0][r] * rli[r]; ss += v * v; Ow[(long)orow * LDO + d0 * 32 + r32e] = (bf16_t)(cvtpk(v, v) & 0xffffu); }
    ss += __shfl_xor(ss, 1); ss += __shfl_xor(ss, 2); ss += __shfl_xor(ss, 4); ss += __shfl_xor(ss, 8); ss += __shfl_xor(ss, 16);
    if (r32e == 0) ssq[(long)(wid * QBLK + orow) * 8] = ss; }
  __syncthreads();
#undef SLOAD
#undef SWRITE
#undef SWAIT
#undef RESC
}
#undef KSWZ
#undef SBAR
}

#define XB_TMO      128
#define XB_XCNT(j)  (256  + 64 * (j))
#define XB_XSUB(j)  (1280 + 64 * (j))
#define XB_XGEN(j)  (2304 + 64 * (j))
#define XB_TOP      3328
#define XB_TOPGEN   3392
#define XCD_BAR_WORDS 3456
#define XB_SPIN_CAP (1u << 18)
__device__ __forceinline__ unsigned xb_ld(unsigned* p)              { return __hip_atomic_load(p, __ATOMIC_RELAXED, __HIP_MEMORY_SCOPE_AGENT); }
__device__ __forceinline__ unsigned xb_add(unsigned* p, unsigned v) { return __hip_atomic_fetch_add(p, v, __ATOMIC_RELAXED, __HIP_MEMORY_SCOPE_AGENT); }
__device__ __forceinline__ unsigned xb_xcc_id() { return (unsigned)__builtin_amdgcn_s_getreg((3 << 11) | 20) & 0xFu; }
#define XB_SPIN(cond, bar) do { unsigned _sp = 0; while (cond) { __builtin_amdgcn_s_sleep(1); \
    if ((++_sp & 255u) == 0u) { if (xb_ld(&(bar)[XB_TMO])) break; if (_sp > XB_SPIN_CAP) { atomicAdd(&(bar)[XB_TMO], 1u); break; } } } } while (0)
struct XcdBarrier { unsigned* bar; unsigned x; volatile LAS unsigned* st; };
__device__ __forceinline__ XcdBarrier xcd_barrier_post(unsigned* bar, volatile LAS unsigned* st) {
    XcdBarrier b; b.bar = bar; b.x = xb_xcc_id(); b.st = st;
    if (threadIdx.x == 0) (void)xb_add(&bar[XB_XCNT(b.x)], 1u);
    return b;
}
__device__ __forceinline__ void xcd_barrier_complete(unsigned* bar, unsigned x, unsigned& nloc, unsigned& nx) {
    const unsigned G = gridDim.x * gridDim.y * gridDim.z;
    unsigned sum, cnt, mine, sp = 0u;
    for (;;) {
        sum = 0u; cnt = 0u; mine = 0u;
#pragma unroll
        for (unsigned j = 0; j < 16; ++j) { const unsigned c = xb_ld(&bar[XB_XCNT(j)]); sum += c; cnt += (c > 0u) ? 1u : 0u; mine = (j == x) ? c : mine; }
        if (sum == G) break;
        __builtin_amdgcn_s_sleep(1);
        if ((++sp & 255u) == 0u) { if (xb_ld(&bar[XB_TMO])) break; if (sp > XB_SPIN_CAP) { atomicAdd(&bar[XB_TMO], 1u); break; } }
    }
    nloc = mine > 0u ? mine : 1u; nx = cnt > 0u ? cnt : 1u;
}
__device__ __forceinline__ void xcd_barrier(const XcdBarrier& b) {
    asm volatile("s_waitcnt vmcnt(0)" ::: "memory");
    __syncthreads();
    if (threadIdx.x == 0) {
        unsigned* bar = b.bar;
        __builtin_amdgcn_s_waitcnt(0);
        unsigned nloc = b.st[0], nx = b.st[1];
        if (nloc == 0u) { xcd_barrier_complete(bar, b.x, nloc, nx); b.st[0] = nloc; b.st[1] = nx; }
        const unsigned old = xb_add(&bar[XB_XSUB(b.x)], 1u);
        const unsigned gen = old / nloc;
        if (old + 1u == (gen + 1u) * nloc) {
            __builtin_amdgcn_fence(__ATOMIC_RELEASE, "agent");
            asm volatile("s_waitcnt vmcnt(0)" ::: "memory");
            const unsigned og = xb_add(&bar[XB_TOP], 1u);
            const unsigned tg = og / nx;
            if (og + 1u == (tg + 1u) * nx) xb_add(&bar[XB_TOPGEN], 1u);
            else XB_SPIN(xb_ld(&bar[XB_TOPGEN]) == tg, bar);
            __builtin_amdgcn_fence(__ATOMIC_ACQUIRE, "agent");
            xb_add(&bar[XB_XGEN(b.x)], 1u);
            asm volatile("s_waitcnt vmcnt(0)" ::: "memory");
        } else {
            XB_SPIN(xb_ld(&bar[XB_XGEN(b.x)]) == gen, bar);
            __builtin_amdgcn_fence(__ATOMIC_ACQUIRE, "agent");
            asm volatile("s_waitcnt vmcnt(0)" ::: "memory");
        }
    }
    __syncthreads();
}

struct Args { const float* in[34]; float* out; unsigned char* ws; int ph_lo, ph_hi; };
enum { I_X = 0, I_P, I_LN0G, I_LN0B, I_WIN, I_QG, I_KG, I_ARE, I_AIM, I_LDT, I_BRE, I_BIM, I_CRE, I_CIM, I_SD, I_WGLU, I_BGLU, I_AOG, I_SOG, I_WOUT,
       I_LN1G, I_LN1B, I_RGW, I_RGB, I_REW, I_REB, I_WG, I_WU, I_WD, I_WPLE, I_WPG, I_BPG, I_LN2G, I_LN2B };

typedef const Args __attribute__((address_space(4)))* KArgP;
__device__ __forceinline__ KArgP kargs() { KArgP p = (KArgP)__builtin_amdgcn_kernarg_segment_ptr(); asm volatile("" : "+s"(p)); return p; }
struct Frame {
    LAS unsigned char* lds; unsigned char* ws; unsigned* ctl;
    int tid, lane, wave, vcu, G, bx;
};

struct TrDesc { const float* W; bf16_t* WT; const float* ks; int K, N, rmode, k0, n0; };
__device__ __forceinline__ void tr_load(const TrDesc& d, f32x4 (&v)[16], int lane) {
    const int lr = lane >> 4, lc = (lane & 15) * 4; const float* p = d.W + (size_t)(d.k0 + lr) * d.N + d.n0 + lc; const size_t st = (size_t)4 * d.N;
#pragma unroll
    for (int i = 0; i < 16; ++i) v[i] = __builtin_nontemporal_load((const f32x4*)(p + i * st));
}
__device__ __forceinline__ void tr_store(const TrDesc& d, const f32x4 (&v)[16], LAS float* scr, int lane) {
    const int lr = lane >> 4, lc = (lane & 15) * 4;
#pragma unroll
    for (int i = 0; i < 16; ++i) { const int kk = 4 * i + lr; f32x4 x = v[i]; if (d.ks) x = x * d.ks[d.k0 + kk];
        scr[kk * 65 + lc + 0] = x[0]; scr[kk * 65 + lc + 1] = x[1]; scr[kk * 65 + lc + 2] = x[2]; scr[kk * 65 + lc + 3] = x[3]; }
    LDS_WAIT(); asm volatile("" ::: "memory");
    const int c = lane & 7;
#pragma unroll
    for (int j = 0; j < 8; ++j) { const int n = (lane >> 3) + 8 * j; const LAS float* s = scr + (8 * c) * 65 + n;
        u32x4 o; o.x = cvt_pk_bf16(s[0 * 65], s[1 * 65]); o.y = cvt_pk_bf16(s[2 * 65], s[3 * 65]); o.z = cvt_pk_bf16(s[4 * 65], s[5 * 65]); o.w = cvt_pk_bf16(s[6 * 65], s[7 * 65]);
        const int ng = d.n0 + n; const int dr = d.rmode == 0 ? ng : ((ng >> 7) * 256 + (ng & 127) + (d.rmode == 2 ? 128 : 0));
        __builtin_nontemporal_store(o, (u32x4*)(d.WT + (size_t)dr * d.K + d.k0 + 8 * c)); }
    LDS_WAIT(); asm volatile("" ::: "memory");
}
__device__ __forceinline__ void ln_row(f32x4 (&v)[8], const float* __restrict__ g, const float* __restrict__ b, int lane) {
    float s = 0.f;
#pragma unroll
    for (int i = 0; i < 8; ++i) s += (v[i][0] + v[i][1]) + (v[i][2] + v[i][3]);
    const float mean = wave_sum(s) * (1.f / DM); float s2 = 0.f;
#pragma unroll
    for (int i = 0; i < 8; ++i) { v[i] = v[i] - mean; s2 += (v[i][0] * v[i][0] + v[i][1] * v[i][1]) + (v[i][2] * v[i][2] + v[i][3] * v[i][3]); }
    const float rstd = rsqrtf(wave_sum(s2) * (1.f / DM) + EPS);
#pragma unroll
    for (int i = 0; i < 8; ++i) { const f32x4 gg = *(const f32x4*)(g + 4 * lane + 256 * i), bb = *(const f32x4*)(b + 4 * lane + 256 * i); v[i] = v[i] * rstd * gg + bb; }
}
__device__ __forceinline__ void store_row(const f32x4 (&v)[8], float* xf, bf16_t* xb, int lane) {
#pragma unroll
    for (int i = 0; i < 8; ++i) { if (xf) *(f32x4*)(xf + 4 * lane + 256 * i) = v[i];
        if (xb) { u32x2 w; w.x = cvt_pk_bf16(v[i][0], v[i][1]); w.y = cvt_pk_bf16(v[i][2], v[i][3]); *(u32x2*)(xb + 4 * lane + 256 * i) = w; } }
}

__device__ __forceinline__ void ssm_build(KArgP a, Frame& F, int l, int g) {
    LAS float* L = (LAS float*)F.lds;
    LAS float* APr = L;
    LAS float* APi = L + 2176;
    LAS float* BBr = L + 4352;
    LAS float* BBi = L + 6400;
    LAS float* Cr = L + 8448;
    LAS float* Ci = L + 10496;
    LAS float* KT = L + 12544;
    const int tid = F.tid;
    LAS float* COr = L + 20736; LAS float* COi = L + 20864;
    if (tid < 128) { const int d = tid >> 6, p = tid & 63; const size_t pi = ((size_t)(l * 2 + d) * NG + g) * NP + p; const float dt = expf(a->in[I_LDT][(l * 2 + d) * NG + g]);
        const float ar = a->in[I_ARE][pi], ai = a->in[I_AIM][pi], zr = dt * ar, zi = dt * ai; const float mg = expf(zr), cz = cosf(zi), sz = sinf(zi);
        const float abr = mg * cz, abi = mg * sz;
        const float sh = sinf(0.5f * zi); const float nr = expm1f(zr) * cz - 2.f * sh * sh, ni = abi;
        const float den = ar * ar + ai * ai; COr[tid] = (nr * ar + ni * ai) / den; COi[tid] = (ni * ar - nr * ai) / den;
        float pr = 1.f, pim = 0.f;
        for (int e = 0; e < 17; ++e) { APr[(d * 17 + e) * 64 + p] = pr; APi[(d * 17 + e) * 64 + p] = pim; const float t = pr * abr - pim * abi; pim = pr * abi + pim * abr; pr = t; } }
    for (int i = tid; i < 2 * 16 * 64; i += 512) { const int d = i >> 10, r = i & 1023; const size_t ci_ = ((size_t)(l * 2 + d) * NG + g) * (NH * NP) + r;
        Cr[i] = a->in[I_CRE][ci_]; Ci[i] = a->in[I_CIM][ci_]; }
    LDS_WAIT(); __syncthreads();
    for (int i = tid; i < 2 * 64 * 16; i += 512) { const int d = i >> 10, r = i & 1023, p = r >> 4, h = r & 15;
        const size_t pi = ((size_t)(l * 2 + d) * NG + g) * NP + p; const float cr = COr[d * 64 + p], ci = COi[d * 64 + p];
        const float br = a->in[I_BRE][pi * NH + h], bi = a->in[I_BIM][pi * NH + h];
        BBr[i] = cr * br - ci * bi; BBi[i] = cr * bi + ci * br; }
    LDS_WAIT(); __syncthreads();
    { const int d = tid >> 8, j = (tid >> 4) & 15, hp = tid & 15; float kacc[16];
#pragma unroll
      for (int h = 0; h < 16; ++h) kacc[h] = 0.f;
      for (int p = 0; p < 64; ++p) { const float xr = APr[(d * 17 + j) * 64 + p], xi = APi[(d * 17 + j) * 64 + p], br = BBr[(d * 64 + p) * 16 + hp], bi = BBi[(d * 64 + p) * 16 + hp];
          const float tr = xr * br - xi * bi, ti = xr * bi + xi * br;
#pragma unroll
          for (int h = 0; h < 16; ++h) kacc[h] += Cr[(d * 16 + h) * 64 + p] * tr - Ci[(d * 16 + h) * 64 + p] * ti; }
#pragma unroll
      for (int h = 0; h < 16; ++h) KT[((d * 16 + j) * 16 + h) * 16 + hp] = kacc[h]; }
    LDS_WAIT(); __syncthreads();
    bf16_t* W1 = (bf16_t*)(F.ws + WS_W + (size_t)l * WL_BYTES + WL_S1) + (size_t)g * 256 * 256;
    bf16_t* W2 = (bf16_t*)(F.ws + WS_W + (size_t)l * WL_BYTES + WL_S2) + (size_t)g * 256 * 512;
    const float* dsk = a->in[I_SD] + ((size_t)l * NG + g) * NH;
    for (int i = tid; i < 256 * 32; i += 512) { const int n = i >> 5, kc = i & 31, sg = kc >> 1, h0 = (kc & 1) * 8; const int d = n >> 7, ri = (n >> 6) & 1, p = n & 63;
        const int e = d == 0 ? 15 - sg : sg; const float xr = APr[(d * 17 + e) * 64 + p], xi = APi[(d * 17 + e) * 64 + p]; float o[8];
#pragma unroll
        for (int q = 0; q < 8; ++q) { const float br = BBr[(d * 64 + p) * 16 + h0 + q], bi = BBi[(d * 64 + p) * 16 + h0 + q]; o[q] = ri == 0 ? xr * br - xi * bi : xr * bi + xi * br; }
        u32x4 w; w.x = cvt_pk_bf16(o[0], o[1]); w.y = cvt_pk_bf16(o[2], o[3]); w.z = cvt_pk_bf16(o[4], o[5]); w.w = cvt_pk_bf16(o[6], o[7]);
        *(u32x4*)(W1 + (size_t)n * 256 + sg * 16 + h0) = w; }
    for (int i = tid; i < 256 * 64; i += 512) { const int n = i >> 6, kc = i & 63, tau = n >> 4, h = n & 15; float o[8];
        if (kc < 32) { const int sg = kc >> 1, h0 = (kc & 1) * 8;
#pragma unroll
            for (int q = 0; q < 8; ++q) { const int hp = h0 + q; float v;
                if (tau > sg) v = KT[((0 * 16 + (tau - sg)) * 16 + h) * 16 + hp];
                else if (sg > tau) v = KT[((1 * 16 + (sg - tau)) * 16 + h) * 16 + hp];
                else v = KT[((0 * 16 + 0) * 16 + h) * 16 + hp] + KT[((1 * 16 + 0) * 16 + h) * 16 + hp] + (hp == h ? dsk[h] : 0.f);
                o[q] = v; }
            u32x4 w; w.x = cvt_pk_bf16(o[0], o[1]); w.y = cvt_pk_bf16(o[2], o[3]); w.z = cvt_pk_bf16(o[4], o[5]); w.w = cvt_pk_bf16(o[6], o[7]);
            *(u32x4*)(W2 + (size_t)n * 512 + sg * 16 + h0) = w;
        } else { const int kk = (kc - 32) * 8, d = kk >> 7, ri = (kk >> 6) & 1, p0 = kk & 63; const int e = d == 0 ? tau + 1 : 16 - tau;
#pragma unroll
            for (int q = 0; q < 8; ++q) { const int p = p0 + q; const float xr = APr[(d * 17 + e) * 64 + p], xi = APi[(d * 17 + e) * 64 + p], cr = Cr[(d * 16 + h) * 64 + p], ci = Ci[(d * 16 + h) * 64 + p];
                o[q] = ri == 0 ? (cr * xr - ci * xi) : -(cr * xi + ci * xr); }
            u32x4 w; w.x = cvt_pk_bf16(o[0], o[1]); w.y = cvt_pk_bf16(o[2], o[3]); w.z = cvt_pk_bf16(o[4], o[5]); w.w = cvt_pk_bf16(o[6], o[7]);
            *(u32x4*)(W2 + (size_t)n * 512 + 256 + kk) = w; }
    }
    __syncthreads();
}

__device__ __forceinline__ void p0_prologue(KArgP a, Frame& F) {
#ifndef PROBE_DUP
#define PROBE_DUP 0
#endif
#define PREP(k) for (int prep_ = 0; prep_ < ((PROBE_DUP >> (k)) & 1) + 1; ++prep_)
    PREP(13) for (int it = F.vcu; it < NL * NG; it += F.G) ssm_build(a, F, it / NG, it % NG);
    __syncthreads();
    LAS float* scr = (LAS float*)(F.lds + F.wave * 16640);
    const int gw = F.vcu * NWAVES + F.wave, NGW = F.G * NWAVES;
    constexpr int I_IN = 32 * 40, I_GLU = 16 * 16, I_OUT = 32 * 32, I_G1 = 32 * 8, I_D1 = 8 * 32, I_PLE = 4 * 32, I_PG = 32 * 32;
    constexpr int PER_L = I_IN + I_GLU + I_OUT + 16 * I_G1 * 2 + 16 * I_D1 + I_PLE + I_PG;
    auto decode = [&](int it, TrDesc& d) {
        const int l = it / PER_L; int r = it - l * PER_L; unsigned char* wl = F.ws + WS_W + (size_t)l * WL_BYTES; d.ks = nullptr; d.rmode = 0;
        if (r < I_IN) { d.W = a->in[I_WIN] + (size_t)l * DM * DIN; d.K = DM; d.N = DIN; d.WT = (bf16_t*)(wl + WL_IN); }
        else if ((r -= I_IN) < I_GLU) { d.W = a->in[I_WGLU] + (size_t)l * SW * SW; d.K = SW; d.N = SW; d.WT = (bf16_t*)(wl + WL_GLU); }
        else if ((r -= I_GLU) < I_OUT) { d.W = a->in[I_WOUT] + (size_t)l * DM * DM; d.K = DM; d.N = DM; d.WT = (bf16_t*)(wl + WL_OUT); d.ks = (r % 32) < 16 ? a->in[I_AOG] + (size_t)l * AW : a->in[I_SOG] + (size_t)l * SW - AW; }
        else if ((r -= I_OUT) < 16 * I_G1) { const int e = r / I_G1; r -= e * I_G1; d.W = a->in[I_WG] + ((size_t)l * NE + e) * DM * DE; d.K = DM; d.N = DE; d.WT = (bf16_t*)(wl + WL_GU) + (size_t)e * 1024 * DM; d.rmode = 1; }
        else if ((r -= 16 * I_G1) < 16 * I_G1) { const int e = r / I_G1; r -= e * I_G1; d.W = a->in[I_WU] + ((size_t)l * NE + e) * DM * DE; d.K = DM; d.N = DE; d.WT = (bf16_t*)(wl + WL_GU) + (size_t)e * 1024 * DM; d.rmode = 2; }
        else if ((r -= 16 * I_G1) < 16 * I_D1) { const int e = r / I_D1; r -= e * I_D1; d.W = a->in[I_WD] + ((size_t)l * NE + e) * DE * DM; d.K = DE; d.N = DM; d.WT = (bf16_t*)(wl + WL_DN) + (size_t)e * DM * DE; }
        else if ((r -= 16 * I_D1) < I_PLE) { d.W = a->in[I_WPLE] + (size_t)l * PLE * DM; d.K = PLE; d.N = DM; d.WT = (bf16_t*)(wl + WL_PLE); }
        else { r -= I_PLE; d.W = a->in[I_WPG] + (size_t)l * DM * DM; d.K = DM; d.N = DM; d.WT = (bf16_t*)(wl + WL_PG); }
        const int kblk = d.K >> 6, nb = r / kblk; d.n0 = nb * 64; d.k0 = (r - nb * kblk) * 64;
    };
    PREP(14) {
        f32x4 va[16], vb[16]; TrDesc da, db; int it = gw;
        if (it < NL * PER_L) { decode(it, da); tr_load(da, va, F.lane); }
        while (it < NL * PER_L) {
            const int it1 = it + NGW; if (it1 < NL * PER_L) { decode(it1, db); tr_load(db, vb, F.lane); }
            tr_store(da, va, scr, F.lane);
            const int it2 = it1 + NGW; if (it1 >= NL * PER_L) break;
            if (it2 < NL * PER_L) { decode(it2, da); tr_load(da, va, F.lane); }
            tr_store(db, vb, scr, F.lane);
            it = it2;
        }
    }
    PREP(15) { const int gt = F.vcu * 512 + F.tid, NT = F.G * 512;
      for (int i = gt; i < NL * 20 * DM; i += NT) { const int l = i / (20 * DM), r = i - l * 20 * DM;
          const int c = r & 3, ln = (r >> 2) & 63, ip = (r >> 8) & 3, jj = (r >> 10) % 20, hf = (r >> 10) / 20, k = 4 * ln + 256 * (4 * hf + ip) + c;
          float* dst = (float*)(F.ws + WS_W + (size_t)l * WL_BYTES + WL_RT);
          dst[r] = jj < 4 ? a->in[I_RGW][((size_t)l * DM + k) * 4 + jj] : a->in[I_REW][((size_t)l * DM + k) * 16 + (jj - 4)]; }
      float* cosT = (float*)(F.ws + WS_TAB); float* sinT = cosT + SEQ * 64;
      for (int i = gt; i < SEQ * 64; i += NT) { const int t = i >> 6, ai = i & 63; const float pos = (float)(ai < 32 ? (t >> 6) : (t & 63));
          const float inv = powf(10000.0f, -(float)(ai & 31) / 32.0f); const float ang = pos * inv; cosT[i] = cosf(ang); sinT[i] = sinf(ang); }
      const float* p = a->in[I_P]; bf16_t* pb = (bf16_t*)(F.ws + WS_PB);
      for (size_t i = (size_t)gt; i < (size_t)NL * T * PLE / 8; i += NT) { const f32x4 x0 = *(const f32x4*)(p + i * 8), x1 = *(const f32x4*)(p + i * 8 + 4); u32x4 w;
          w.x = cvt_pk_bf16(x0[0], x0[1]); w.y = cvt_pk_bf16(x0[2], x0[3]); w.z = cvt_pk_bf16(x1[0], x1[1]); w.w = cvt_pk_bf16(x1[2], x1[3]); *(u32x4*)(pb + i * 8) = w; }
    }
    bf16_t* XB = (bf16_t*)(F.ws + WS_XB);
    PREP(16) for (int m = gw; m < T; m += NGW) { f32x4 v[8];
#pragma unroll
        for (int i = 0; i < 8; ++i) v[i] = *(const f32x4*)(a->in[I_X] + (size_t)m * DM + 4 * F.lane + 256 * i);
        ln_row(v, a->in[I_LN0G], a->in[I_LN0B], F.lane); store_row(v, nullptr, XB + (size_t)m * DM, F.lane); }
}

__device__ __forceinline__ void ph_ln1(KArgP a, Frame& F, int l, bool dummy) {
    float* XF = (float*)(F.ws + WS_XF); bf16_t* XB = (bf16_t*)(F.ws + (dummy ? WS_Q : WS_XB)); const bf16_t* XBI = (const bf16_t*)(F.ws + WS_XB); const bf16_t* MB = (const bf16_t*)(F.ws + WS_FP); (void)XF;
    const float* g = a->in[I_LN1G] + (size_t)l * DM; const float* b = a->in[I_LN1B] + (size_t)l * DM;
    const f32x4* wimg = (const f32x4*)(F.ws + WS_W + (size_t)l * WL_BYTES + WL_RT);
    unsigned* ltok = dummy ? (unsigned*)(F.ws + WS_SS) : (unsigned*)(F.ws + WS_LT) + (size_t)l * NE * 8192; float* lgate = dummy ? (float*)(F.ws + WS_SS + 4 * MiB) : (float*)(F.ws + WS_LG) + (size_t)l * NE * 8192;
    unsigned* cnt = F.ctl + CW_CNT + (dummy ? l + 4 : l) * 16 * 64;
    LAS f32x4* WL = (LAS f32x4*)F.lds; LAS int* ENT_E = (LAS int*)(F.lds + 81920); LAS unsigned* ENT_T = (LAS unsigned*)(F.lds + 81920 + 256); LAS float* ENT_G = (LAS float*)(F.lds + 81920 + 512);
    for (int blk = F.vcu; blk * 32 < T; blk += F.G) {
#pragma unroll 1
        for (int pass = 0; pass < 2; ++pass) {
            const int base = blk * 32 + F.wave * 4 + pass * 2;
            f32x4 x[2][8];
#pragma unroll
            for (int r = 0; r < 2; ++r) {
#pragma unroll
                for (int i = 0; i < 8; ++i) { const size_t o = (size_t)(base + r) * DM + 4 * F.lane + 256 * i; const u32x2 xw = *(const u32x2*)(XBI + o); const u32x2 mw = *(const u32x2*)(MB + o);
                    x[r][i][0] = bf_lo(xw.x) * ALPHA + bf_lo(mw.x); x[r][i][1] = bf_hi(xw.x) * ALPHA + bf_hi(mw.x); x[r][i][2] = bf_lo(xw.y) * ALPHA + bf_lo(mw.y); x[r][i][3] = bf_hi(xw.y) * ALPHA + bf_hi(mw.y); }
                ln_row(x[r], g, b, F.lane); store_row(x[r], nullptr, XB + (size_t)((dummy ? (base + r) & (T / 4 - 1) : base + r)) * DM, F.lane); }
#ifndef LN1_MODE
#define LN1_MODE 0
#endif
            if (dummy && LN1_MODE == 1) continue;
            f32x2 xp[8][4];
#pragma unroll
            for (int i = 0; i < 8; ++i)
#pragma unroll
                for (int c = 0; c < 4; ++c) xp[i][c] = (f32x2){x[0][i][c], x[1][i][c]};
            f32x2 acc2[20];
#pragma unroll
            for (int j = 0; j < 20; ++j) acc2[j] = (f32x2){0.f, 0.f};
#pragma unroll
            for (int hf = 0; hf < 2; ++hf) {
                __syncthreads();
#pragma unroll
                for (int q = 0; q < 10; ++q) WL[F.tid + 512 * q] = wimg[hf * 5120 + F.tid + 512 * q];
                LDS_WAIT(); __syncthreads();
                if (dummy && LN1_MODE == 2) continue;
                f32x4 wc[4], wn[4];
#pragma unroll
                for (int ip = 0; ip < 4; ++ip) wc[ip] = WL[ip * 64 + F.lane];
#pragma unroll
                for (int j = 0; j < 20; ++j) {
                    if (j < 19) {
#pragma unroll
                        for (int ip = 0; ip < 4; ++ip) wn[ip] = WL[((j + 1) * 4 + ip) * 64 + F.lane]; }
#pragma unroll
                    for (int ip = 0; ip < 4; ++ip)
#pragma unroll
                        for (int c = 0; c < 4; ++c) acc2[j] = __builtin_elementwise_fma(xp[hf * 4 + ip][c], (f32x2){wc[ip][c], wc[ip][c]}, acc2[j]);
#pragma unroll
                    for (int ip = 0; ip < 4; ++ip) wc[ip] = wn[ip];
                }
            }
            float acc[2][20];
#pragma unroll
            for (int j = 0; j < 20; ++j) { acc[0][j] = acc2[j][0]; acc[1][j] = acc2[j][1]; }
            if (dummy && (LN1_MODE == 2 || LN1_MODE == 3)) { if (LN1_MODE == 3) { float t = 0.f;
#pragma unroll
                for (int j = 0; j < 20; ++j) t += acc[0][j] + acc[1][j]; if (t == 123.456f) ENT_G[0] = t; } continue; }
            float lg[2][20];
#pragma unroll
            for (int j = 0; j < 20; ++j) { const float bj = j < 4 ? a->in[I_RGB][l * 4 + j] : a->in[I_REB][l * 16 + (j - 4)]; lg[0][j] = wave_sum(acc[0][j]) + bj; lg[1][j] = wave_sum(acc[1][j]) + bj; }
#pragma unroll
            for (int r = 0; r < 2; ++r) {
                int gi = 0; float gm = lg[r][0];
#pragma unroll
                for (int j = 1; j < 4; ++j) if (lg[r][j] > gm) { gm = lg[r][j]; gi = j; }
                float gs = 0.f;
#pragma unroll
                for (int j = 0; j < 4; ++j) gs += expf(lg[r][j] - gm);
                const float gtop = 1.0f / gs;
                float sel[4];
#pragma unroll
                for (int j = 0; j < 4; ++j) sel[j] = gi == 0 ? lg[r][4 + j] : gi == 1 ? lg[r][8 + j] : gi == 2 ? lg[r][12 + j] : lg[r][16 + j];
                int i1 = 0; float m1 = sel[0];
#pragma unroll
                for (int j = 1; j < 4; ++j) if (sel[j] > m1) { m1 = sel[j]; i1 = j; }
                int i2 = (i1 == 0) ? 1 : 0; float m2 = sel[i1 == 0 ? 1 : 0];
#pragma unroll
                for (int j = 0; j < 4; ++j) if (j != i1 && sel[j] > m2) { m2 = sel[j]; i2 = j; }
                const float e2 = expf(m2 - m1); const float w1 = gtop / (1.0f + e2), w2 = gtop * e2 / (1.0f + e2);
                if (F.lane == 0) { const int q = (F.wave * 4 + pass * 2 + r) * 2; ENT_E[q] = gi * 4 + i1; ENT_T[q] = (unsigned)(base + r); ENT_G[q] = w1;
                    ENT_E[q + 1] = gi * 4 + i2; ENT_T[q + 1] = (unsigned)(base + r) | 0x10000u; ENT_G[q + 1] = w2; }
            }
        }
        LDS_WAIT(); __syncthreads();
        if (F.wave == 0 && !(dummy && LN1_MODE != 0)) {
            const int e = ENT_E[F.lane]; const unsigned tk = ENT_T[F.lane]; const float gt = ENT_G[F.lane];
            int rank = 0, mycnt = 0;
#pragma unroll
            for (int k = 0; k < 16; ++k) { const unsigned long long m = __ballot(e == k); if (e == k) rank = __popcll(m & ((1ull << F.lane) - 1ull)); if (F.lane == k) mycnt = __popcll(m); }
            unsigned bse = 0u; if (F.lane < 16 && mycnt > 0) bse = __hip_atomic_fetch_add(cnt + F.lane * 64, (unsigned)mycnt, RLX_AGENT);
            const unsigned pos = (unsigned)__shfl((int)bse, e) + (unsigned)rank;
            ltok[e * 8192 + pos] = tk; lgate[e * 8192 + pos] = gt;
        }
    }
    __syncthreads();
}
__device__ __forceinline__ void ph_comb(KArgP a, Frame& F, int l, bool dummy) {
    float* XF = (float*)(F.ws + WS_XF); bf16_t* XB = (bf16_t*)(F.ws + (dummy ? WS_Q : WS_XB)); const bf16_t* XBI = (const bf16_t*)(F.ws + WS_XB); const bf16_t* PE = (const bf16_t*)(F.ws + WS_UX); (void)XF; const bf16_t* FP = (const bf16_t*)(F.ws + WS_FP);
    const float* g = a->in[I_LN2G] + (size_t)l * DM; const float* b = a->in[I_LN2B] + (size_t)l * DM;
    const int gw = F.vcu * NWAVES + F.wave, NGW = F.G * NWAVES;
    for (int m = gw; m < T; m += NGW) { f32x4 v[8];
#pragma unroll
        for (int i = 0; i < 8; ++i) { const int c = 4 * F.lane + 256 * i; const u32x2 xw = *(const u32x2*)(XBI + (size_t)m * DM + c); const f32x4 x = {bf_lo(xw.x), bf_hi(xw.x), bf_lo(xw.y), bf_hi(xw.y)};
            const u32x2 f0 = *(const u32x2*)(FP + ((size_t)m * 2) * DM + c), f1 = *(const u32x2*)(FP + ((size_t)m * 2 + 1) * DM + c), pe = *(const u32x2*)(PE + (size_t)m * DM + c);
            v[i][0] = (x[0] * ALPHA + bf_lo(pe.x)) + (bf_lo(f0.x) + bf_lo(f1.x)); v[i][1] = (x[1] * ALPHA + bf_hi(pe.x)) + (bf_hi(f0.x) + bf_hi(f1.x));
            v[i][2] = (x[2] * ALPHA + bf_lo(pe.y)) + (bf_lo(f0.y) + bf_lo(f1.y)); v[i][3] = (x[3] * ALPHA + bf_hi(pe.y)) + (bf_hi(f0.y) + bf_hi(f1.y)); }
        ln_row(v, g, b, F.lane);
        if (l == NL - 1 && !dummy) store_row(v, a->out + (size_t)m * DM, nullptr, F.lane); else store_row(v, nullptr, XB + (size_t)(dummy ? m & (T / 4 - 1) : m) * DM, F.lane); }
}
__device__ __forceinline__ void moe_info(Frame& F, int l) {
    LAS int* info = (LAS int*)(F.lds + LX_INFO);
    __syncthreads();
    if (F.tid == 0) { int base = 0;
        for (int e = 0; e < 16; ++e) { int c = (int)__hip_atomic_load(F.ctl + CW_CNT + (l * 16 + e) * 64, RLX_AGENT); c = c > 8192 ? 8192 : c; info[e] = c; info[16 + e] = base; base += (c + 255) >> 8; }
        info[32] = base; int x = 4 * base - 256; x = x < 0 ? 0 : (x > 256 ? 256 : x); info[33] = x; }
    LDS_WAIT(); __syncthreads();
}

constexpr int N_PHASES = 1 + NL * 9;
__global__ void __launch_bounds__(NWAVES * 64, 2) fwd_kernel(Args args) {
    extern __shared__ __attribute__((aligned(16))) unsigned char lds_raw[];
    Frame F;
    F.lds = (LAS unsigned char*)lds_raw; F.ws = nullptr; F.ctl = nullptr;
    F.tid = threadIdx.x; F.lane = F.tid & 63; F.wave = __builtin_amdgcn_readfirstlane(F.tid >> 6);
    F.G = gridDim.x; F.bx = blockIdx.x; F.vcu = (F.G % 8 == 0) ? (F.bx % 8) * (F.G / 8) + F.bx / 8 : F.bx;
    volatile LAS unsigned* MISC = (volatile LAS unsigned*)(F.lds + LX_MISC);
    for (int u = F.tid; u < (LDS_BYTES - LX_MISC) / 4; u += NWAVES * 64) MISC[u] = 0u;
    __syncthreads();
#if MK_ONE_LAUNCH
    XcdBarrier bar = xcd_barrier_post((unsigned*)(args.ws + WS_CTL) + CW_BAR, MISC + 8);
#define GRID_BAR() xcd_barrier(bar)
#else
#define GRID_BAR() do { } while (0)
#endif
    const int lo = args.ph_lo, hi = args.ph_hi;
#ifndef PH_MASK
#define PH_MASK 0x3ff
#endif
#define EN(s) ((PH_MASK >> (s)) & 1)
#ifndef PROBE_DUP
#define PROBE_DUP 0
#endif
#define REP(k) for (int rep_ = 0; rep_ < ((PROBE_DUP >> (k)) & 1) + 1; ++rep_)
#define IN(k) (lo <= (k) && (k) < hi)
#define BOTH(k) (IN(k) && IN((k) + 1))
#define PH_SETUP() KArgP ap = kargs(); unsigned char* ws = ap->ws; F.ws = ws; F.ctl = (unsigned*)(ws + WS_CTL); \
    { int tid_ = threadIdx.x, bx_ = blockIdx.x, g_ = gridDim.x; asm volatile("" : "+v"(tid_), "+s"(bx_), "+s"(g_)); F.tid = tid_; F.lane = tid_ & 63; F.wave = __builtin_amdgcn_readfirstlane(tid_ >> 6); \
      F.G = g_; F.bx = bx_; F.vcu = (g_ % 8 == 0) ? (bx_ % 8) * (g_ / 8) + bx_ / 8 : bx_; } \
    float* XF = (float*)(ws + WS_XF); bf16_t* XB = (bf16_t*)(ws + WS_XB); bf16_t* Qb = (bf16_t*)(ws + WS_Q); bf16_t* Kb = (bf16_t*)(ws + WS_K); bf16_t* Vb = (bf16_t*)(ws + WS_V); \
    bf16_t* UX = (bf16_t*)(ws + WS_UX); float* SS = (float*)(ws + WS_SS); bf16_t* CAT = (bf16_t*)(ws + WS_CAT); bf16_t* Yb = (bf16_t*)(ws + WS_Y); \
    float* SSQA = (float*)(ws + WS_SSQ); float* SSQS = SSQA + T * 8; bf16_t* PL = (bf16_t*)(ws + WS_PL); bf16_t* HID = (bf16_t*)(ws + WS_HID); bf16_t* FP = (bf16_t*)(ws + WS_FP); \
    const float* cosT = (const float*)(ws + WS_TAB); const float* sinT = cosT + SEQ * 64; unsigned char* wl = ws + WS_W + (size_t)l * WL_BYTES; \
    (void)XF; (void)XB; (void)Qb; (void)Kb; (void)Vb; (void)UX; (void)SS; (void)CAT; (void)Yb; (void)SSQA; (void)SSQS; (void)PL; (void)HID; (void)FP; (void)cosT; (void)sinT; (void)wl; (void)ap
    if (EN(0) && IN(0)) REP(0) { const int l = 0; PH_SETUP(); p0_prologue(ap, F); if (BOTH(0)) GRID_BAR(); }

    for (int l = 0; l < NL; ++l) {
        const int pb = 1 + l * 9;
        if (EN(1) && IN(pb + 0)) REP(1) { PH_SETUP();
            pg8::InProjSched S{(const char*)XB, (const char*)(wl + WL_IN), 0, F.G == 256 ? F.vcu : -1, (size_t)256 * DM * 2, (size_t)256 * DM * 2};
            pg8::EpiInProj<2> E{Qb, Kb, Vb, UX, ap->in[I_QG] + l * 128, ap->in[I_KG] + l * 128, cosT, sinT, (LAS float*)(F.lds + LX_P)};
            pg8::gemm_phase<pg8::EpiInProj<2>, pg8::InProjSched, true>(F.lds, DM, DM, S, E);
            if (BOTH(pb + 0)) GRID_BAR();
        }
        if (EN(2) && IN(pb + 1)) REP(2) { PH_SETUP();
            {
                pg8::InProjSched S{(const char*)XB, (const char*)(wl + WL_IN), 1, F.G == 256 ? F.vcu : -1, (size_t)256 * DM * 2, (size_t)256 * DM * 2};
                pg8::EpiInProj<1> E{Qb, Kb, Vb, UX, ap->in[I_QG] + l * 128, ap->in[I_KG] + l * 128, cosT, sinT, (LAS float*)(F.lds + LX_P)};
                REP(21) pg8::gemm_phase<pg8::EpiInProj<1>, pg8::InProjSched, true, true>(F.lds, DM, DM, S, E);
            }
            {
                const int loc_ = F.vcu & 31; const bool on = loc_ < 16 && F.G == 256;
                pg8::TileSched S2{(const char*)((const bf16_t*)(ws + WS_PB) + (size_t)l * T * PLE), (const char*)(wl + WL_PLE), T / 256, DM / 256, 128, on ? (F.vcu >> 5) * 16 + loc_ : (F.G == 256 ? -1 : F.vcu),
                                  (size_t)256 * PLE * 2, (size_t)256 * PLE * 2, false, 0, F.G == 256 ? 128 : 256};
                pg8::EpiBf16P8 E2{PL, DM};
                pg8::gemm_phase<pg8::EpiBf16P8, pg8::TileSched, true>(F.lds, PLE, PLE, S2, E2);
            }
            REP(11)
            {
                const int loc_ = F.vcu & 31; const bool act = loc_ >= 16 && F.G == 256;
                const int un = act ? (F.vcu >> 5) * 16 + (loc_ - 16) : 0, b = un >> 6, g = un & 63;
                const char* uxp = (const char*)(UX + (size_t)un * NCH * 512);
                float* sscr = SS + (size_t)un * 256 * 256;
                pg8::OneSched S1{uxp, (const char*)(wl + WL_S1) + (size_t)g * 256 * 256 * 2, b, g, act};
                pg8::EpiS1 E1{sscr};
                REP(18) pg8::gemm_phase<pg8::EpiS1, pg8::OneSched, true>(F.lds, 256, 512, S1, E1);
                VM_WAIT(); __syncthreads();
                REP(19) {
                    const int sg = F.tid >> 7, pr = F.tid & 127, d = pr >> 6, p = pr & 63; const size_t pi = ((size_t)(l * 2 + d) * NG + g) * NP + p;
                    float ar = 1.f, ai = 0.f;
                    if (act) { const float dt = expf(ap->in[I_LDT][(l * 2 + d) * NG + g]); const float zr = 16.f * dt * ap->in[I_ARE][pi], zi = 16.f * dt * ap->in[I_AIM][pi]; const float mg = expf(zr); ar = mg * cosf(zi); ai = mg * sinf(zi); }
                    const float* sre = sscr + d * 128 + p; LAS float* EX = (LAS float*)(F.lds + LX_P);
                    float xr = 0.f, xi = 0.f;
                    if (act) {
                        for (int cb = 0; cb < 64; cb += 16) { float sr[16], si[16];
#pragma unroll
                            for (int q = 0; q < 16; ++q) { const int qq = sg * 64 + cb + q, c = d == 0 ? qq : 255 - qq; sr[q] = sre[(size_t)c * 256]; si[q] = sre[(size_t)c * 256 + 64]; }
#pragma unroll
                            for (int q = 0; q < 16; ++q) { const float nr = ar * xr - ai * xi + sr[q], ni = ar * xi + ai * xr + si[q]; xr = nr; xi = ni; } }
                        EX[(sg * 128 + pr) * 2] = xr; EX[(sg * 128 + pr) * 2 + 1] = xi;
                    }
                    LDS_WAIT(); __syncthreads();
                    if (act) {
                        float br = ar, bi = ai;
#pragma unroll
                        for (int k = 0; k < 6; ++k) { const float t = br * br - bi * bi; bi = 2.f * br * bi; br = t; }
                        xr = 0.f; xi = 0.f;
                        for (int r = 0; r < sg; ++r) { const float er = EX[(r * 128 + pr) * 2], ei = EX[(r * 128 + pr) * 2 + 1]; const float nr = br * xr - bi * xi + er, ni = br * xi + bi * xr + ei; xr = nr; xi = ni; }
                        bf16_t* ux = UX + (size_t)un * NCH * 512 + 256 + d * 128 + p;
                        for (int cb = 0; cb < 64; cb += 16) { float sr[16], si[16];
#pragma unroll
                            for (int q = 0; q < 16; ++q) { const int qq = sg * 64 + cb + q, c = d == 0 ? qq : 255 - qq; sr[q] = sre[(size_t)c * 256]; si[q] = sre[(size_t)c * 256 + 64]; }
#pragma unroll
                            for (int q = 0; q < 16; ++q) { const int qq = sg * 64 + cb + q, c = d == 0 ? qq : 255 - qq;
                                ux[(size_t)c * 512] = (bf16_t)(cvt_pk_bf16(xr, xr) & 0xffffu); ux[(size_t)c * 512 + 64] = (bf16_t)(cvt_pk_bf16(xi, xi) & 0xffffu);
                                const float nr = ar * xr - ai * xi + sr[q], ni = ar * xi + ai * xr + si[q]; xr = nr; xi = ni; } }
                    }
                }
                VM_WAIT(); __syncthreads();
                pg8::OneSched S2{uxp, (const char*)(wl + WL_S2) + (size_t)g * 256 * 512 * 2, b, g, act};
                pg8::EpiS2 E2{Yb};
                REP(20) pg8::gemm_phase<pg8::EpiS2, pg8::OneSched, true>(F.lds, 512, 512, S2, E2);
            }
            if (BOTH(pb + 1)) GRID_BAR();
        }
        if (EN(3) && IN(pb + 2)) REP(3) { PH_SETUP();
            for (int un = F.vcu; un < 256; un += F.G) {
                const int bk = un >> 6, hl = (un >> 4) & 3, qb = un & 15, b = bk >> 1, kvh = bk & 1, h = kvh * 4 + hl;
                const size_t row0 = (size_t)b * SEQ + qb * 256;
                att::attn_dense_body(Qb + row0 * AW + h * 128, Kb + (size_t)b * SEQ * KVW + kvh * 128, Vb + (size_t)b * SEQ * KVW + kvh * 128,
                                     CAT + row0 * DM + h * 128, SSQA + row0 * 8 + h, SEQ, (char*)lds_raw);
            }
            if (BOTH(pb + 2)) GRID_BAR();
        }
        if (EN(4) && IN(pb + 3)) REP(4) { PH_SETUP();
            pg8::TileSched S{(const char*)Yb, (const char*)(wl + WL_GLU), T / 256, SW / 256, F.G, F.bx, (size_t)256 * SW * 2, (size_t)256 * SW * 2};
            pg8::EpiGlu E{Yb, ap->in[I_BGLU] + (size_t)l * SW, CAT, SSQS};
            pg8::gemm_phase<pg8::EpiGlu, pg8::TileSched, true>(F.lds, SW, SW, S, E);
            {
                const bool split = (F.G == 256);
                pg8::TileSched S2{(const char*)((const bf16_t*)(ws + WS_PB) + (size_t)l * T * PLE), (const char*)(wl + WL_PLE), T / 256, DM / 256, split ? 128 : F.G, split ? F.bx - 128 : -1,
                                  (size_t)256 * PLE * 2, (size_t)256 * PLE * 2, false, 128, 128};
                pg8::EpiBf16P8 E2{PL, DM};
                pg8::gemm_phase<pg8::EpiBf16P8, pg8::TileSched, true>(F.lds, PLE, PLE, S2, E2);
            }
            if (BOTH(pb + 3)) GRID_BAR();
        }
        if (EN(5) && IN(pb + 4)) REP(5) { PH_SETUP();
            pg8::TileSched S{(const char*)CAT, (const char*)(wl + WL_OUT), T / 256, DM / 256, F.G, F.bx, (size_t)256 * DM * 2, (size_t)256 * DM * 2};
            LAS f32x2* st = (LAS f32x2*)(F.lds + LX_P);
            pg8::Unit u0; const bool have = S.next(0, u0); pg8::Unit u1; const bool more = S.next(1, u1); S.dup = (PROBE_DUP >> 17) & 1;
            __syncthreads();
            if (have && F.tid < 256) { const int row = u0.pm * 256 + F.tid; float sa = 0.f, ssum = 0.f;
#pragma unroll
                for (int k = 0; k < 8; ++k) sa += SSQA[(size_t)row * 8 + k];
#pragma unroll
                for (int k = 0; k < 16; ++k) ssum += SSQS[(size_t)row * 16 + k];
                const float ra = rsqrtf(sa * (1.f / AW) + EPS), rs = rsqrtf(ssum * (1.f / SW) + EPS); st[F.tid] = (f32x2){ra / rs, rs}; }
            LDS_WAIT(); __syncthreads();
            if (!more) {
                pg8::EpiOut E{(bf16_t*)(ws + WS_FP), st};
                pg8::gemm_phase<pg8::EpiOut, pg8::TileSched, true>(F.lds, DM, DM, S, E);
            } else if (F.tid == 0) { __hip_atomic_store(F.ctl + CW_TMO, 0x7f0u, RLX_AGENT); }
            if (BOTH(pb + 4)) GRID_BAR();
        }
        if (EN(6) && IN(pb + 5)) REP(6) { PH_SETUP(); ph_ln1(ap, F, l, (PROBE_DUP >> 6 & 1) && rep_ == 0); if (BOTH(pb + 5)) GRID_BAR(); }
        if (EN(7) && IN(pb + 6)) REP(7) { PH_SETUP();
            moe_info(F, l);
            int R0, C0, R1, C1; pg8::stage_rc(F.tid * 16, R0, C0); pg8::stage_rc(F.tid * 16 + 8192, R1, C1);
            pg8::MoeGuSched S{(const LAS int*)(F.lds + LX_INFO), (const char*)XB, (const char*)(wl + WL_GU), (const unsigned*)(ws + WS_LT) + (size_t)l * NE * 8192, F.G, F.vcu, R0, R1, (unsigned)C0 * 2u, (unsigned)C1 * 2u};
            pg8::EpiGu E{HID};
            REP(10) pg8::gemm_phase<pg8::EpiGu, pg8::MoeGuSched, true>(F.lds, DM, DM, S, E);
            const int xg = ((const LAS int*)(F.lds + LX_INFO))[33];
            pg8::PgSched S2{(const char*)XB, (const char*)(wl + WL_PG), 0, 256 - xg, F.vcu - xg, (size_t)256 * DM * 2, (size_t)256 * DM * 2};
            REP(12) { pg8::EpiPg E2{ap->in[I_BPG] + (size_t)l * DM, PL, UX};
            pg8::gemm_phase<pg8::EpiPg, pg8::PgSched, true>(F.lds, DM, DM, S2, E2); }
            if (BOTH(pb + 6)) GRID_BAR();
        }
        if (EN(8) && IN(pb + 7)) REP(8) { PH_SETUP();
            moe_info(F, l);
            const int xg = ((const LAS int*)(F.lds + LX_INFO))[33];
            {
                pg8::PgSched S2{(const char*)XB, (const char*)(wl + WL_PG), 256 - xg, xg, F.vcu, (size_t)256 * DM * 2, (size_t)256 * DM * 2};
                pg8::EpiPg E2{ap->in[I_BPG] + (size_t)l * DM, PL, UX};
                pg8::gemm_phase<pg8::EpiPg, pg8::PgSched, true>(F.lds, DM, DM, S2, E2);
            }
            pg8::MoeDnSched S{(const LAS int*)(F.lds + LX_INFO), (const char*)HID, (const char*)(wl + WL_DN), F.G - xg, F.vcu - xg};
            pg8::EpiDown E{FP, (const unsigned*)(ws + WS_LT) + (size_t)l * NE * 8192, (const float*)(ws + WS_LG) + (size_t)l * NE * 8192};
            pg8::gemm_phase<pg8::EpiDown, pg8::MoeDnSched, true>(F.lds, DE, DE, S, E);
            if (BOTH(pb + 7)) GRID_BAR();
        }
        if (EN(9) && IN(pb + 8)) REP(9) { PH_SETUP(); ph_comb(ap, F, l, (PROBE_DUP >> 9 & 1) && rep_ == 0); if (BOTH(pb + 8)) GRID_BAR(); }
    }
#undef IN
#undef BOTH
}

extern "C" void kernel_launch(void* const* d_in, const int* in_sizes, int n_in, void* d_out, int out_size, void* d_ws, size_t ws_size, hipStream_t stream) {
    static int grid = 0;
    if (grid == 0) {
        if (n_in != 34 || out_size != T * DM || ws_size < WS_END) { fprintf(stderr, "kernel_launch: unexpected shapes: n_in %d out %d ws %zu (need %zu)\n", n_in, out_size, ws_size, (size_t)WS_END); grid = -1; return; }
        int dev = 0, cus = 0, per_cu = 0;
        if (hipGetDevice(&dev) != hipSuccess || hipDeviceGetAttribute(&cus, hipDeviceAttributeMultiprocessorCount, dev) != hipSuccess) { grid = -1; return; }
        if (hipFuncSetAttribute((const void*)fwd_kernel, hipFuncAttributeMaxDynamicSharedMemorySize, LDS_BYTES) != hipSuccess) { fprintf(stderr, "kernel_launch: hipFuncSetAttribute failed\n"); grid = -1; return; }
        if (hipOccupancyMaxActiveBlocksPerMultiprocessor(&per_cu, (const void*)fwd_kernel, NWAVES * 64, LDS_BYTES) != hipSuccess || per_cu < 1) fprintf(stderr, "kernel_launch: occupancy query reports %d\n", per_cu);
        (void)hipGetLastError();
        grid = cus;
        if (grid != 256) fprintf(stderr, "kernel_launch: %d CUs; this kernel is built for 256\n", grid);
    }
    if (grid < 0) return;
    (void)hipMemsetAsync((char*)d_ws + WS_CTL, 0, CTL_ZERO_BYTES, stream);
    Args a{};
    for (int i = 0; i < 34; ++i) a.in[i] = (const float*)d_in[i];
    a.out = (float*)d_out; a.ws = (unsigned char*)d_ws;
#if MK_ONE_LAUNCH
    a.ph_lo = 0; a.ph_hi = N_PHASES;
    hipLaunchKernelGGL(fwd_kernel, dim3(grid), dim3(NWAVES * 64), LDS_BYTES, stream, a);
#else
    for (int ph = 0; ph < N_PHASES; ++ph) { a.ph_lo = ph; a.ph_hi = ph + 1; hipLaunchKernelGGL(fwd_kernel, dim3(grid), dim3(NWAVES * 64), LDS_BYTES, stream, a); }
#endif
    const hipError_t le = hipPeekAtLastError();
    if (le != hipSuccess) fprintf(stderr, "kernel_launch: launch failed: %s\n", hipGetErrorName(le));
}
```

```cpp
#include <hip/hip_runtime.h>
#include <cstdio>
#include <cstdint>
#include <cmath>

#ifndef MK_ONE_LAUNCH
#define MK_ONE_LAUNCH 1
#endif

#define LAS __attribute__((address_space(3)))
#define GAS __attribute__((address_space(1)))
typedef unsigned short bf16_t;
typedef short bf16x8 __attribute__((ext_vector_type(8)));
typedef short s16x4 __attribute__((ext_vector_type(4)));
typedef float f32x2 __attribute__((ext_vector_type(2)));
typedef float f32x4 __attribute__((ext_vector_type(4)));
typedef float f32x8 __attribute__((ext_vector_type(8)));
typedef float f32x16 __attribute__((ext_vector_type(16)));
typedef unsigned u32x2 __attribute__((ext_vector_type(2)));
typedef unsigned u32x4 __attribute__((ext_vector_type(4)));

constexpr int NL = 4, BATCH = 2, SEQ = 4096, T = BATCH * SEQ, DM = 2048;
constexpr int AW = 1024, KVW = 256, SW = 1024, DIN = 2560, NE = 16, DE = 512, PLE = 256;
constexpr int NG = 64, NP = 64, NH = 16, CH = 16, NCH = SEQ / CH;
constexpr float ALPHA = 1.6817928305074290f;
constexpr float EPS = 1e-6f;
constexpr int NWAVES = 8;

constexpr size_t MiB = 1u << 20;
constexpr size_t WS_CTL = 0, CTL_ZERO_BYTES = 1 * MiB;
constexpr size_t WS_TAB = 1 * MiB;
constexpr size_t WS_PB = 3 * MiB;
constexpr size_t WS_W = 19 * MiB;
constexpr size_t WL_IN = 0, WL_GLU = 10 * MiB, WL_OUT = 12 * MiB, WL_GU = 20 * MiB, WL_DN = 84 * MiB, WL_PLE = 116 * MiB, WL_PG = 117 * MiB,
                 WL_S1 = 125 * MiB, WL_S2 = 133 * MiB, WL_RT = 149 * MiB, WL_BYTES = 150 * MiB;
constexpr size_t WS_ACT = WS_W + NL * WL_BYTES;
constexpr size_t WS_XF = WS_ACT, WS_XB = WS_XF + 64 * MiB, WS_Q = WS_XB + 32 * MiB, WS_K = WS_Q + 16 * MiB, WS_V = WS_K + 4 * MiB,
                 WS_UX = WS_V + 4 * MiB, WS_SS = WS_UX + 32 * MiB, WS_CAT = WS_SS + 32 * MiB, WS_Y = WS_CAT + 32 * MiB, WS_SSQ = WS_Y + 16 * MiB,
                 WS_PL = WS_SSQ + 1 * MiB, WS_HID = WS_PL + 32 * MiB, WS_FP = WS_HID + 20 * MiB, WS_LT = WS_FP + 64 * MiB, WS_LG = WS_LT + 2 * MiB,
                 WS_END = WS_LG + 2 * MiB;
constexpr int CW_TMO = 0, CW_CODE = 1, CW_BAR = 4096, CW_CNT = 16384;

constexpr int RING_BYTES = 131072;
constexpr int LX_P = RING_BYTES;
constexpr int LX_INFO = RING_BYTES + 8192;
constexpr int LX_MISC = RING_BYTES + 8192 + 512;
constexpr int LDS_BYTES = 147456;

#define RLX_AGENT __ATOMIC_RELAXED, __HIP_MEMORY_SCOPE_AGENT
#define LDS_WAIT() asm volatile("s_waitcnt lgkmcnt(0)" ::: "memory")
#define VM_WAIT() asm volatile("s_waitcnt vmcnt(0)" ::: "memory")
__device__ __forceinline__ unsigned cvt_pk_bf16(float lo, float hi) { unsigned r; asm volatile("v_cvt_pk_bf16_f32 %0, %1, %2" : "=v"(r) : "v"(lo), "v"(hi)); return r; }
__device__ __forceinline__ float bf_lo(unsigned w) { return __uint_as_float(w << 16); }
__device__ __forceinline__ float bf_hi(unsigned w) { return __uint_as_float(w & 0xffff0000u); }
__device__ __forceinline__ float dpp_f(float v, const int ctrl) { return v; }
#define DPP_ADD(v, ctrl) v += __builtin_bit_cast(float, __builtin_amdgcn_update_dpp(0, __builtin_bit_cast(int, v), ctrl, 0xF, 0xF, false))
__device__ __forceinline__ float row16_sum(float v) {
    DPP_ADD(v, 0xB1); DPP_ADD(v, 0x4E); DPP_ADD(v, 0x141); DPP_ADD(v, 0x140); return v;
}
__device__ __forceinline__ float wave_sum(float v) {
    v = row16_sum(v); const int b = __builtin_bit_cast(int, v);
    return (__builtin_bit_cast(float, __builtin_amdgcn_readlane(b, 0)) + __builtin_bit_cast(float, __builtin_amdgcn_readlane(b, 16))) +
           (__builtin_bit_cast(float, __builtin_amdgcn_readlane(b, 32)) + __builtin_bit_cast(float, __builtin_amdgcn_readlane(b, 48)));
}
__device__ __forceinline__ float sigmoidf_(float z) { return __builtin_amdgcn_rcpf(1.0f + __builtin_amdgcn_exp2f(-1.4426950408889634f * z)); }
__device__ __forceinline__ float gelu_tanh(float x) {
    const float u = 1.5957691216057308f * (x + 0.044715f * x * x * x);
    return x * sigmoidf_(u);
}

namespace pg8 {
constexpr int BM = 256, BK = 64, HALF = 128, HTB = HALF * BK * 2, STAGE_BYTES = 8 * HTB;
__host__ __device__ __forceinline__ int lds_byte(int r, int c) { const int st = (r >> 4) * 2 + (c >> 5), rr = r & 15, cc = c & 31, ob = rr * 64 + cc * 2; return st * 1024 + (ob ^ (((ob >> 9) & 1) << 5)); }
__host__ __device__ __forceinline__ void stage_rc(int b, int& R, int& C) { const int st = b / 1024, sb = b % 1024, swz = sb ^ (((sb >> 9) & 1) << 5); R = (st >> 1) * 16 + swz / 64; C = (st & 1) * 32 + (swz % 64) / 2; }
__host__ __device__ __forceinline__ int perm32(int rho) { const int n = rho >> 4, i = rho & 15; return 8 * (i >> 2) + 4 * n + (i & 3); }
__host__ __device__ __forceinline__ int brow_id(int R) { return R; }
__host__ __device__ __forceinline__ int brow_p8(int R) { return (R & ~31) + perm32(R & 31); }
__host__ __device__ __forceinline__ int brow_rope(int R) { return ((R >> 4) & 1) * 64 + (R >> 5) * 16 + (R & 15); }

struct Unit { const char* A; const char* B; int pm, pn, x0, x1, x2; unsigned a00, a01, a10, a11; };

template <class Epi, class Sched, bool ALIGN_EPI, bool HALF_M = false>
__device__ __forceinline__ void gemm_phase(LAS unsigned char* lds, const int K, const int lda, const Sched& S, const Epi& E) {
    int tid = threadIdx.x; asm volatile("" : "+v"(tid));
    const int wid = __builtin_amdgcn_readfirstlane(tid >> 6), lane = tid & 63, wr = wid >> 2, wc = wid & 3, fr = lane & 15, fq = lane >> 4;
    int nt = K / BK; asm volatile("" : "+s"(nt));
    unsigned voffA[2], voffB[2];
#pragma unroll
    for (int i = 0; i < 2; ++i) { int R, C; stage_rc(tid * 16 + i * 8192, R, C); const int Rb = Epi::brow(R);
        voffA[i] = (unsigned)(R * lda + C) * 2u; voffB[i] = (unsigned)(Rb * K + C) * 2u; }
    const size_t kstep = (size_t)(BK * 2);
    const size_t hstepA = (size_t)HALF * lda * 2, hstepB = (size_t)HALF * K * 2;
    const unsigned ldsw = (unsigned)wid * 1024u;
    const int aoff = lds_byte(wr * 64 + fr, fq * 8), boff = lds_byte(wc * 32 + fr, fq * 8);
#define PG8_SA(b, h) (((b) * 2 + (h)) * HTB)
#define PG8_SB(b, h) ((4 + (b) * 2 + (h)) * HTB)
#define PG8_GL(src, bufoff, i_) __builtin_amdgcn_global_load_lds((const unsigned*)(src), (LAS unsigned*)(lds + (bufoff) + ldsw + (i_) * 8192), 16, 0, 0)
#define PG8_STAGE_B(bufoff, gbase) do { PG8_GL((gbase) + voffB[0], bufoff, 0); PG8_GL((gbase) + voffB[1], bufoff, 1); } while (0)
#define PG8_STAGE_A(bufoff, gbase, h, o0, o1) do { if constexpr (Sched::GATHER) { PG8_GL((gbase) + (o0), bufoff, 0); PG8_GL((gbase) + (o1), bufoff, 1); } \
        else { PG8_GL((gbase) + (h) * hstepA + voffA[0], bufoff, 0); PG8_GL((gbase) + (h) * hstepA + voffA[1], bufoff, 1); } } while (0)
#define PG8_LDA(dst, b, h) do { _Pragma("unroll") for (int m = 0; m < 4; ++m) _Pragma("unroll") for (int k = 0; k < 2; ++k) dst[m][k] = *(const LAS bf16x8*)(lds + PG8_SA(b, h) + aoff + m * 2048 + k * 1024); } while (0)
#define PG8_LDB(dst, b, h) do { _Pragma("unroll") for (int n = 0; n < 2; ++n) _Pragma("unroll") for (int k = 0; k < 2; ++k) dst[n][k] = *(const LAS bf16x8*)(lds + PG8_SB(b, h) + boff + n * 2048 + k * 1024); } while (0)
#define PG8_MMA(ai, bj, At, Bt) do { __builtin_amdgcn_s_setprio(1); _Pragma("unroll") for (int m = 0; m < 4; ++m) _Pragma("unroll") for (int n = 0; n < 2; ++n) _Pragma("unroll") for (int k = 0; k < 2; ++k) \
        acc[ai][bj][m][n] = __builtin_amdgcn_mfma_f32_16x16x32_bf16(Bt[n][k], At[m][k], acc[ai][bj][m][n], 0, 0, 0); __builtin_amdgcn_s_setprio(0); } while (0)
#define PG8_WAIT_V(n) asm volatile("s_waitcnt vmcnt(" #n ")" ::: "memory")
#define PG8_WAIT_L(n) asm volatile("s_waitcnt lgkmcnt(" #n ")" ::: "memory")
#define PG8_BAR __builtin_amdgcn_s_barrier()
#define PG8_SCHED __builtin_amdgcn_sched_barrier(0)
    Unit cur, nxt; int ui = 0;
    if (!S.next(0, cur)) return;
    f32x4 acc[2][2][4][2];
#pragma unroll
    for (int a = 0; a < 2; ++a)
#pragma unroll
        for (int b = 0; b < 2; ++b)
#pragma unroll
            for (int m = 0; m < 4; ++m)
#pragma unroll
                for (int n = 0; n < 2; ++n) acc[a][b][m][n] = (f32x4){0.f, 0.f, 0.f, 0.f};
    bf16x8 At[4][2], B0[2][2], B1[2][2];
    const char* cA = cur.A; const char* cB = cur.B;
    PG8_STAGE_B(PG8_SB(0, 0), cB); PG8_STAGE_B(PG8_SB(0, 1), cB + hstepB); PG8_STAGE_A(PG8_SA(0, 0), cA, 0, cur.a00, cur.a01); if constexpr (!HALF_M) PG8_STAGE_A(PG8_SA(0, 1), cA, 1, cur.a10, cur.a11);
    if (wr == 1) PG8_BAR;
    if constexpr (HALF_M) PG8_WAIT_V(0); else PG8_WAIT_V(2);
    PG8_BAR;
    PG8_STAGE_B(PG8_SB(1, 0), cB + kstep); PG8_STAGE_A(PG8_SA(1, 0), cA + kstep, 0, cur.a00, cur.a01); PG8_STAGE_B(PG8_SB(1, 1), cB + hstepB + kstep);
    PG8_WAIT_V(6); PG8_BAR;
    for (;;) {
        const bool has_next = S.next(ui + 1, nxt);
        const char* nA = has_next ? nxt.A : cA; const char* nB = has_next ? nxt.B : cB;
        if (!has_next) { nxt.a00 = cur.a00; nxt.a01 = cur.a01; nxt.a10 = cur.a10; nxt.a11 = cur.a11; }
        for (int t = 0; t < nt; t += 2) {
            const bool last = (t == nt - 2);
            const char* a1 = cA + (size_t)(t + 1) * kstep;
            const char* a2 = last ? nA : cA + (size_t)(t + 2) * kstep; const char* b2 = last ? nB : cB + (size_t)(t + 2) * kstep;
            const char* a3 = a2 + kstep; const char* b3 = b2 + kstep;
            const unsigned s00 = last ? nxt.a00 : cur.a00, s01 = last ? nxt.a01 : cur.a01, s10 = last ? nxt.a10 : cur.a10, s11 = last ? nxt.a11 : cur.a11;
            if constexpr (Epi::MID) { if (t == (nt >> 1)) { int fr_ = fr; asm volatile("" : "+v"(fr_)); E.mid(acc, cur, wr, wc, fr_, fq); } }
            if constexpr (!HALF_M) {
            PG8_LDB(B0, 0, 0); PG8_LDB(B1, 0, 1); PG8_SCHED; PG8_LDA(At, 0, 0); PG8_STAGE_A(PG8_SA(1, 1), a1, 1, cur.a10, cur.a11);
            PG8_WAIT_V(8); PG8_WAIT_L(0); PG8_BAR; PG8_MMA(0, 0, At, B0); PG8_MMA(0, 1, At, B1); PG8_BAR; PG8_SCHED;
            PG8_LDA(At, 0, 1); PG8_STAGE_B(PG8_SB(0, 0), b2); PG8_STAGE_B(PG8_SB(0, 1), b2 + hstepB); PG8_STAGE_A(PG8_SA(0, 0), a2, 0, s00, s01);
            PG8_WAIT_V(8); PG8_WAIT_L(0); PG8_BAR; PG8_MMA(1, 0, At, B0); PG8_MMA(1, 1, At, B1); PG8_BAR; PG8_SCHED;
            PG8_LDB(B0, 1, 0); PG8_LDB(B1, 1, 1); PG8_SCHED; PG8_LDA(At, 1, 0); PG8_STAGE_A(PG8_SA(0, 1), a2, 1, s10, s11);
            PG8_WAIT_V(8); PG8_WAIT_L(0); PG8_BAR; PG8_MMA(0, 0, At, B0); PG8_MMA(0, 1, At, B1); PG8_BAR; PG8_SCHED;
            PG8_LDA(At, 1, 1); PG8_STAGE_B(PG8_SB(1, 0), b3); PG8_STAGE_B(PG8_SB(1, 1), b3 + hstepB); PG8_STAGE_A(PG8_SA(1, 0), a3, 0, s00, s01);
            PG8_WAIT_V(8); PG8_WAIT_L(0); PG8_BAR; PG8_MMA(1, 0, At, B0); PG8_MMA(1, 1, At, B1); PG8_BAR; PG8_SCHED;
            } else {
            PG8_LDB(B0, 0, 0); PG8_LDB(B1, 0, 1); PG8_SCHED; PG8_LDA(At, 0, 0);
            PG8_WAIT_V(6); PG8_WAIT_L(0); PG8_BAR; PG8_MMA(0, 0, At, B0); PG8_MMA(0, 1, At, B1); PG8_BAR; PG8_SCHED;
            PG8_STAGE_B(PG8_SB(0, 0), b2); PG8_STAGE_B(PG8_SB(0, 1), b2 + hstepB); PG8_STAGE_A(PG8_SA(0, 0), a2, 0, s00, s01);
            PG8_WAIT_V(6); PG8_WAIT_L(0); PG8_BAR; PG8_BAR; PG8_SCHED;
            PG8_LDB(B0, 1, 0); PG8_LDB(B1, 1, 1); PG8_SCHED; PG8_LDA(At, 1, 0);
            PG8_WAIT_V(6); PG8_WAIT_L(0); PG8_BAR; PG8_MMA(0, 0, At, B0); PG8_MMA(0, 1, At, B1); PG8_BAR; PG8_SCHED;
            PG8_STAGE_B(PG8_SB(1, 0), b3); PG8_STAGE_B(PG8_SB(1, 1), b3 + hstepB); PG8_STAGE_A(PG8_SA(1, 0), a3, 0, s00, s01);
            PG8_WAIT_V(6); PG8_WAIT_L(0); PG8_BAR; PG8_BAR; PG8_SCHED;
            }
        }
        if constexpr (ALIGN_EPI) { if (wr == 0) PG8_BAR; }
        { int fr_ = fr, fq_ = fq; asm volatile("" : "+v"(fr_), "+v"(fq_)); E(acc, cur, wr, wc, fr_, fq_); }
        if (!has_next) break;
#pragma unroll
        for (int a = 0; a < 2; ++a)
#pragma unroll
            for (int b = 0; b < 2; ++b)
#pragma unroll
                for (int m = 0; m < 4; ++m)
#pragma unroll
                    for (int n = 0; n < 2; ++n) acc[a][b][m][n] = (f32x4){0.f, 0.f, 0.f, 0.f};
        cur = nxt; cA = nA; cB = nB; ++ui;
        if constexpr (ALIGN_EPI) { if (wr == 1) PG8_BAR; }
    }
    PG8_WAIT_V(0);
    if constexpr (!ALIGN_EPI) { if (wr == 0) PG8_BAR; }
    PG8_BAR;
#undef PG8_SA
#undef PG8_SB
#undef PG8_GL
#undef PG8_STAGE_A
#undef PG8_STAGE_B
#undef PG8_LDA
#undef PG8_LDB
#undef PG8_MMA
#undef PG8_WAIT_V
#undef PG8_WAIT_L
#undef PG8_BAR
#undef PG8_SCHED
}

constexpr int NXCD = 8, WGM = 8;
struct TileSched {
    static constexpr bool GATHER = false;
    const char* A; const char* B; int nM, nN, G, c; size_t astep, bstep; bool dup = false; int first = 0, count = 1 << 30;
    __device__ __forceinline__ bool next(int i_, Unit& u) const {
        const int nwg = nM * nN; if (c < 0) return false;
        const int i = dup ? (i_ > 1 ? 99999 : 0) : i_;
        const long L0 = (long)i * G + c; if (L0 >= count) return false; const long L = L0 + first; if (L >= nwg) return false;
        int wgid = (int)L; { const int q = nwg / NXCD, r = nwg % NXCD, xcd = wgid % NXCD, off = wgid / NXCD; wgid = (xcd < r ? xcd * (q + 1) : r * (q + 1) + (xcd - r) * q) + off; }
        const int nig = WGM * nN, gid = wgid / nig, fm = gid * WGM, gsz = (nM - fm) < WGM ? (nM - fm) : WGM;
        u.pm = fm + ((wgid % nig) % gsz); u.pn = (wgid % nig) / gsz; u.x0 = u.x1 = u.x2 = 0; u.a00 = u.a01 = u.a10 = u.a11 = 0u;
        u.A = A + (size_t)u.pm * astep; u.B = B + (size_t)u.pn * bstep; return true;
    }
};
struct InProjSched {
    static constexpr bool GATHER = false;
    const char* A; const char* B; int part, c; size_t astep, bstep;
    __device__ __forceinline__ bool next(int i, Unit& u) const {
        if (i > 0 || c < 0 || c >= 256) return false; const int xcd = c >> 5, loc = c & 31; int half = 0;
        if (part == 0) { const int sl = loc >> 2; u.pm = 4 * xcd + (loc & 3); u.pn = sl < 6 ? 4 + sl : sl - 6; }
        else { if (loc >= 16) return false; u.pm = 4 * xcd + (loc & 3); half = (loc >> 2) & 1; u.pn = 2 + (loc >> 3); }
        u.x0 = u.x1 = 0; u.x2 = u.pm * 256 + half * 128; u.a00 = u.a01 = u.a10 = u.a11 = 0u; u.A = A + (size_t)u.pm * astep + (size_t)half * (astep >> 1); u.B = B + (size_t)u.pn * bstep; return true;
    }
};
struct PgSched {
    static constexpr bool GATHER = false;
    const char* A; const char* B; int j0, count, c; size_t astep, bstep;
    __device__ __forceinline__ bool next(int i, Unit& u) const {
        if (i > 0 || c < 0 || c >= count) return false; const int j = j0 + c;
        u.pm = j >> 3; u.pn = j & 7; u.x0 = u.x1 = u.x2 = 0; u.a00 = u.a01 = u.a10 = u.a11 = 0u; u.A = A + (size_t)u.pm * astep; u.B = B + (size_t)u.pn * bstep; return true;
    }
};
struct OneSched {
    static constexpr bool GATHER = false;
    const char* A; const char* B; int pm, pn; bool active;
    __device__ __forceinline__ bool next(int i, Unit& u) const {
        if (i > 0 || !active) return false;
        u.A = A; u.B = B; u.pm = pm; u.pn = pn; u.x0 = u.x1 = u.x2 = 0; u.a00 = u.a01 = u.a10 = u.a11 = 0u; return true;
    }
};
struct MoeGuSched {
    static constexpr bool GATHER = true;
    const LAS int* info; const char* XB; const char* W; const unsigned* ltok; int G, c; int R0, R1; unsigned c0, c1;
    __device__ __forceinline__ bool next(int i, Unit& u) const {
        const int idx = i * G + c, ntile = info[32]; if (idx >= 4 * ntile) return false;
        const int tile = idx >> 2, j = idx & 3; int e = 0;
#pragma unroll
        for (int k = 1; k < 16; ++k) if (tile >= info[16 + k]) e = k;
        const int tl = tile - info[16 + e], cnt = info[e];
        u.A = XB; u.B = W + ((size_t)e * 1024 + (size_t)j * 256) * (DM * 2); u.pm = tile; u.pn = j; u.x0 = e; u.x1 = tl * 256; u.x2 = cnt;
        const unsigned* lt = ltok + e * 8192 + tl * 256;
        const int p00 = R0, p01 = R1, p10 = 128 + R0, p11 = 128 + R1;
        const unsigned t00 = (tl * 256 + p00 < cnt) ? (lt[p00] & 0xffffu) : 0u, t01 = (tl * 256 + p01 < cnt) ? (lt[p01] & 0xffffu) : 0u;
        const unsigned t10 = (tl * 256 + p10 < cnt) ? (lt[p10] & 0xffffu) : 0u, t11 = (tl * 256 + p11 < cnt) ? (lt[p11] & 0xffffu) : 0u;
        u.a00 = t00 * (DM * 2) + c0; u.a01 = t01 * (DM * 2) + c1; u.a10 = t10 * (DM * 2) + c0; u.a11 = t11 * (DM * 2) + c1; return true;
    }
};
struct MoeDnSched {
    static constexpr bool GATHER = false;
    const LAS int* info; const char* HID; const char* W; int G, c;
    __device__ __forceinline__ bool next(int i, Unit& u) const {
        const int idx = i * G + c, ntile = info[32]; if (c < 0 || idx >= 8 * ntile) return false;
        const int tile = idx >> 3, j = idx & 7; int e = 0;
#pragma unroll
        for (int k = 1; k < 16; ++k) if (tile >= info[16 + k]) e = k;
        const int tl = tile - info[16 + e];
        u.A = HID + (size_t)tile * 256 * (DE * 2); u.B = W + ((size_t)e * DM + (size_t)j * 256) * (DE * 2); u.pm = tile; u.pn = j; u.x0 = e; u.x1 = tl * 256; u.x2 = info[e];
        u.a00 = u.a01 = u.a10 = u.a11 = 0u; return true;
    }
};

typedef const f32x4 (&AccRef)[2][2][4][2];
template <int NAI> struct EpiInProj {
    static constexpr bool MID = false; static __host__ __device__ int brow(int R) { return brow_rope(R); }
    bf16_t *Q, *Kb, *Vb, *UX; const float *gq, *gk, *cosT, *sinT; LAS float* P;
    __device__ __forceinline__ void operator()(AccRef acc, const Unit& u, int wr, int wc, int fr, int fq) const {
        const int rl0 = wr * 64 + fr, dlo = 16 * wc + 4 * fq;
        if (u.pn <= 4) {
#pragma unroll
            for (int ai = 0; ai < NAI; ++ai)
#pragma unroll
                for (int m = 0; m < 4; ++m)
#pragma unroll
                    for (int bj = 0; bj < 2; ++bj) {
                        const f32x4 a = acc[ai][bj][m][0], b = acc[ai][bj][m][1];
                        float s = (a[0] * a[0] + a[1] * a[1]) + (a[2] * a[2] + a[3] * a[3]) + (b[0] * b[0] + b[1] * b[1]) + (b[2] * b[2] + b[3] * b[3]);
                        s += __shfl_xor(s, 16); s += __shfl_xor(s, 32);
                        if (fq == 0) P[((ai * 128 + m * 16 + rl0) * 2 + bj) * 4 + wc] = s;
                    }
            asm volatile("s_waitcnt lgkmcnt(0)" ::: "memory"); __builtin_amdgcn_s_barrier(); asm volatile("" ::: "memory");
            const float* g = (u.pn < 4) ? gq : gk;
            const f32x4 glo = *(const f32x4*)(g + dlo), ghi = *(const f32x4*)(g + 64 + dlo);
#pragma unroll
            for (int ai = 0; ai < NAI; ++ai)
#pragma unroll
                for (int m = 0; m < 4; ++m) {
                    const int rl = ai * 128 + m * 16 + rl0, row = u.x2 + rl, t = row & (SEQ - 1);
                    const f32x4 cs = *(const f32x4*)(cosT + t * 64 + dlo), sn = *(const f32x4*)(sinT + t * 64 + dlo);
#pragma unroll
                    for (int bj = 0; bj < 2; ++bj) {
                        const f32x4 pv = *(const LAS f32x4*)(P + (rl * 2 + bj) * 4);
                        const float rstd = rsqrtf(((pv[0] + pv[1]) + (pv[2] + pv[3])) * (1.0f / 128.0f) + EPS);
                        const f32x4 lo = acc[ai][bj][m][0] * rstd * glo, hi = acc[ai][bj][m][1] * rstd * ghi;
                        const f32x4 olo = lo * cs - hi * sn, ohi = hi * cs + lo * sn;
                        bf16_t* dst = (u.pn < 4) ? Q + (size_t)row * AW + (2 * u.pn + bj) * 128 + dlo : Kb + (size_t)row * KVW + bj * 128 + dlo;
                        u32x2 w0, w1; w0.x = cvt_pk_bf16(olo[0], olo[1]); w0.y = cvt_pk_bf16(olo[2], olo[3]); w1.x = cvt_pk_bf16(ohi[0], ohi[1]); w1.y = cvt_pk_bf16(ohi[2], ohi[3]);
                        *(u32x2*)dst = w0; *(u32x2*)(dst + 64) = w1;
                    }
                }
        } else if (u.pn == 5) {
#pragma unroll
            for (int ai = 0; ai < NAI; ++ai)
#pragma unroll
                for (int m = 0; m < 4; ++m) {
                    const int row = u.x2 + ai * 128 + m * 16 + rl0;
#pragma unroll
                    for (int bj = 0; bj < 2; ++bj)
#pragma unroll
                        for (int n = 0; n < 2; ++n) { const f32x4 v = acc[ai][bj][m][n]; u32x2 w; w.x = cvt_pk_bf16(v[0], v[1]); w.y = cvt_pk_bf16(v[2], v[3]);
                            *(u32x2*)(Vb + (size_t)row * KVW + bj * 128 + n * 64 + dlo) = w; }
                }
        } else {
#pragma unroll
            for (int ai = 0; ai < NAI; ++ai)
#pragma unroll
                for (int m = 0; m < 4; ++m) {
                    const int row = u.x2 + ai * 128 + m * 16 + rl0, b = row >> 12, t = row & (SEQ - 1), c = t >> 4, sg = t & 15;
#pragma unroll
                    for (int bj = 0; bj < 2; ++bj)
#pragma unroll
                        for (int n = 0; n < 2; ++n) { const f32x4 v = acc[ai][bj][m][n]; u32x2 w; w.x = cvt_pk_bf16(v[0], v[1]); w.y = cvt_pk_bf16(v[2], v[3]);
                            const int g = (u.pn - 6) * 16 + bj * 8 + n * 4 + wc;
                            *(u32x2*)(UX + ((size_t)((b * NG + g) * NCH + c)) * 512 + sg * 16 + 4 * fq) = w; }
                }
        }
    }
};
struct EpiS1 {
    static constexpr bool MID = false; static __host__ __device__ int brow(int R) { return brow_id(R); }
    float* S;
    __device__ __forceinline__ void operator()(AccRef acc, const Unit& u, int wr, int wc, int fr, int fq) const {
#pragma unroll
        for (int ai = 0; ai < 2; ++ai)
#pragma unroll
            for (int m = 0; m < 4; ++m) { float* rp = S + (size_t)(ai * 128 + wr * 64 + m * 16 + fr) * 256 + wc * 32 + 4 * fq;
#pragma unroll
                for (int bj = 0; bj < 2; ++bj)
#pragma unroll
                    for (int n = 0; n < 2; ++n) *(f32x4*)(rp + bj * 128 + n * 16) = acc[ai][bj][m][n]; }
    }
};
struct EpiS2 {
    static constexpr bool MID = false; static __host__ __device__ int brow(int R) { return brow_id(R); }
    bf16_t* Y;
    __device__ __forceinline__ void operator()(AccRef acc, const Unit& u, int wr, int wc, int fr, int fq) const {
        const int b = u.pm, g = u.pn;
#pragma unroll
        for (int ai = 0; ai < 2; ++ai)
#pragma unroll
            for (int m = 0; m < 4; ++m) { const int c = ai * 128 + wr * 64 + m * 16 + fr;
#pragma unroll
                for (int bj = 0; bj < 2; ++bj)
#pragma unroll
                    for (int n = 0; n < 2; ++n) { const f32x4 v = acc[ai][bj][m][n]; const int tau = bj * 8 + wc * 2 + n; u32x2 w;
                        w.x = cvt_pk_bf16(gelu_tanh(v[0]), gelu_tanh(v[1])); w.y = cvt_pk_bf16(gelu_tanh(v[2]), gelu_tanh(v[3]));
                        *(u32x2*)(Y + (size_t)(b * SEQ + c * 16 + tau) * SW + g * 16 + 4 * fq) = w; } }
    }
};
struct EpiGlu {
    static constexpr bool MID = false; static __host__ __device__ int brow(int R) { return brow_p8(R); }
    const bf16_t* Y; const float* bias; bf16_t* CAT; float* SSQS;
    __device__ __forceinline__ void operator()(AccRef acc, const Unit& u, int wr, int wc, int fr, int fq) const {
        const int colw = u.pn * 256 + wc * 32 + 8 * fq;
        f32x4 bv[2][2];
#pragma unroll
        for (int bj = 0; bj < 2; ++bj)
#pragma unroll
            for (int n = 0; n < 2; ++n) bv[bj][n] = *(const f32x4*)(bias + colw + bj * 128 + 4 * n);
#pragma unroll
        for (int ai = 0; ai < 2; ++ai)
#pragma unroll
            for (int m = 0; m < 4; ++m) { const int row = u.pm * 256 + ai * 128 + wr * 64 + m * 16 + fr; float ss = 0.f;
#pragma unroll
                for (int bj = 0; bj < 2; ++bj) { const int col = colw + bj * 128; const u32x4 yw = *(const u32x4*)(Y + (size_t)row * SW + col);
                    const f32x4 z0 = acc[ai][bj][m][0] + bv[bj][0], z1 = acc[ai][bj][m][1] + bv[bj][1];
                    float o[8];
                    o[0] = bf_lo(yw.x) * sigmoidf_(z0[0]); o[1] = bf_hi(yw.x) * sigmoidf_(z0[1]); o[2] = bf_lo(yw.y) * sigmoidf_(z0[2]); o[3] = bf_hi(yw.y) * sigmoidf_(z0[3]);
                    o[4] = bf_lo(yw.z) * sigmoidf_(z1[0]); o[5] = bf_hi(yw.z) * sigmoidf_(z1[1]); o[6] = bf_lo(yw.w) * sigmoidf_(z1[2]); o[7] = bf_hi(yw.w) * sigmoidf_(z1[3]);
#pragma unroll
                    for (int k = 0; k < 8; ++k) ss += o[k] * o[k];
                    u32x4 w; w.x = cvt_pk_bf16(o[0], o[1]); w.y = cvt_pk_bf16(o[2], o[3]); w.z = cvt_pk_bf16(o[4], o[5]); w.w = cvt_pk_bf16(o[6], o[7]);
                    *(u32x4*)(CAT + (size_t)row * DM + AW + col) = w; }
                ss += __shfl_xor(ss, 16); ss += __shfl_xor(ss, 32);
                if (fq == 0) SSQS[(size_t)row * 16 + u.pn * 4 + wc] = ss; }
    }
};
struct EpiBf16P8 {
    static constexpr bool MID = false; static __host__ __device__ int brow(int R) { return brow_p8(R); }
    bf16_t* O; int ldc;
    __device__ __forceinline__ void operator()(AccRef acc, const Unit& u, int wr, int wc, int fr, int fq) const {
        const int colw = u.pn * 256 + wc * 32 + 8 * fq;
#pragma unroll
        for (int ai = 0; ai < 2; ++ai)
#pragma unroll
            for (int m = 0; m < 4; ++m) { bf16_t* rp = O + (size_t)(u.pm * 256 + ai * 128 + wr * 64 + m * 16 + fr) * ldc + colw;
#pragma unroll
                for (int bj = 0; bj < 2; ++bj) { const f32x4 v0 = acc[ai][bj][m][0], v1 = acc[ai][bj][m][1]; u32x4 w;
                    w.x = cvt_pk_bf16(v0[0], v0[1]); w.y = cvt_pk_bf16(v0[2], v0[3]); w.z = cvt_pk_bf16(v1[0], v1[1]); w.w = cvt_pk_bf16(v1[2], v1[3]);
                    *(u32x4*)(rp + bj * 128) = w; } }
    }
};
struct EpiOut {
    static constexpr bool MID = true; static __host__ __device__ int brow(int R) { return brow_p8(R); }
    bf16_t* M; const LAS f32x2* st;
    __device__ __forceinline__ void mid(f32x4 (&acc)[2][2][4][2], const Unit& u, int wr, int wc, int fr, int fq) const {
#pragma unroll
        for (int ai = 0; ai < 2; ++ai)
#pragma unroll
            for (int m = 0; m < 4; ++m) { const float r = st[ai * 128 + wr * 64 + m * 16 + fr].x;
#pragma unroll
                for (int bj = 0; bj < 2; ++bj)
#pragma unroll
                    for (int n = 0; n < 2; ++n) acc[ai][bj][m][n] *= r; }
    }
    __device__ __forceinline__ void operator()(AccRef acc, const Unit& u, int wr, int wc, int fr, int fq) const {
        const int colw = u.pn * 256 + wc * 32 + 8 * fq;
#pragma unroll
        for (int ai = 0; ai < 2; ++ai)
#pragma unroll
            for (int m = 0; m < 4; ++m) { const int rl = ai * 128 + wr * 64 + m * 16 + fr; const float rs = st[rl].y;
                bf16_t* rp = M + (size_t)(u.pm * 256 + rl) * DM + colw;
#pragma unroll
                for (int bj = 0; bj < 2; ++bj) { const f32x4 v0 = acc[ai][bj][m][0] * rs, v1 = acc[ai][bj][m][1] * rs; u32x4 w;
                    w.x = cvt_pk_bf16(v0[0], v0[1]); w.y = cvt_pk_bf16(v0[2], v0[3]); w.z = cvt_pk_bf16(v1[0], v1[1]); w.w = cvt_pk_bf16(v1[2], v1[3]);
                    *(u32x4*)(rp + bj * 128) = w; } }
    }
};
struct EpiGu {
    static constexpr bool MID = false; static __host__ __device__ int brow(int R) { return brow_p8(R); }
    bf16_t* HID;
    __device__ __forceinline__ void operator()(AccRef acc, const Unit& u, int wr, int wc, int fr, int fq) const {
#pragma unroll
        for (int ai = 0; ai < 2; ++ai)
#pragma unroll
            for (int m = 0; m < 4; ++m) { const int rl = ai * 128 + wr * 64 + m * 16 + fr; float o[8];
#pragma unroll
                for (int n = 0; n < 2; ++n)
#pragma unroll
                    for (int j = 0; j < 4; ++j) { const float g = acc[ai][0][m][n][j], up = acc[ai][1][m][n][j]; o[n * 4 + j] = g * sigmoidf_(g) * up; }
                u32x4 w; w.x = cvt_pk_bf16(o[0], o[1]); w.y = cvt_pk_bf16(o[2], o[3]); w.z = cvt_pk_bf16(o[4], o[5]); w.w = cvt_pk_bf16(o[6], o[7]);
                *(u32x4*)(HID + ((size_t)u.pm * 256 + rl) * DE + u.pn * 128 + wc * 32 + 8 * fq) = w; }
    }
};
struct EpiPg {
    static constexpr bool MID = false; static __host__ __device__ int brow(int R) { return brow_p8(R); }
    const float* bias; const bf16_t* PL; bf16_t* PO;
    __device__ __forceinline__ void operator()(AccRef acc, const Unit& u, int wr, int wc, int fr, int fq) const {
        const int colw = u.pn * 256 + wc * 32 + 8 * fq;
        f32x4 bv[2][2];
#pragma unroll
        for (int bj = 0; bj < 2; ++bj)
#pragma unroll
            for (int n = 0; n < 2; ++n) bv[bj][n] = *(const f32x4*)(bias + colw + bj * 128 + 4 * n);
#pragma unroll
        for (int ai = 0; ai < 2; ++ai)
#pragma unroll
            for (int m = 0; m < 4; ++m) { const size_t ro = (size_t)(u.pm * 256 + ai * 128 + wr * 64 + m * 16 + fr) * DM + colw;
#pragma unroll
                for (int bj = 0; bj < 2; ++bj) { const u32x4 pw = *(const u32x4*)(PL + ro + bj * 128); const f32x4 z0 = acc[ai][bj][m][0] + bv[bj][0], z1 = acc[ai][bj][m][1] + bv[bj][1]; u32x4 w;
                    w.x = cvt_pk_bf16(sigmoidf_(z0[0]) * bf_lo(pw.x), sigmoidf_(z0[1]) * bf_hi(pw.x)); w.y = cvt_pk_bf16(sigmoidf_(z0[2]) * bf_lo(pw.y), sigmoidf_(z0[3]) * bf_hi(pw.y));
                    w.z = cvt_pk_bf16(sigmoidf_(z1[0]) * bf_lo(pw.z), sigmoidf_(z1[1]) * bf_hi(pw.z)); w.w = cvt_pk_bf16(sigmoidf_(z1[2]) * bf_lo(pw.w), sigmoidf_(z1[3]) * bf_hi(pw.w));
                    *(u32x4*)(PO + ro + bj * 128) = w; } }
    }
};
struct EpiDown {
    static constexpr bool MID = false; static __host__ __device__ int brow(int R) { return brow_p8(R); }
    bf16_t* FP; const unsigned* ltok; const float* lgate;
    __device__ __forceinline__ void operator()(AccRef acc, const Unit& u, int wr, int wc, int fr, int fq) const {
        const int colw = u.pn * 256 + wc * 32 + 8 * fq;
#pragma unroll
        for (int ai = 0; ai < 2; ++ai)
#pragma unroll
            for (int m = 0; m < 4; ++m) { const int pos = u.x1 + ai * 128 + wr * 64 + m * 16 + fr;
                if (pos < u.x2) { const unsigned ent = ltok[u.x0 * 8192 + pos]; const float gt = lgate[u.x0 * 8192 + pos];
                    bf16_t* rp = FP + ((size_t)(ent & 0xffffu) * 2 + (ent >> 16)) * DM + colw;
#pragma unroll
                    for (int bj = 0; bj < 2; ++bj) { const f32x4 v0 = acc[ai][bj][m][0] * gt, v1 = acc[ai][bj][m][1] * gt; u32x4 w;
                        w.x = cvt_pk_bf16(v0[0], v0[1]); w.y = cvt_pk_bf16(v0[2], v0[3]); w.z = cvt_pk_bf16(v1[0], v1[1]); w.w = cvt_pk_bf16(v1[2], v1[3]);
                        *(u32x4*)(rp + bj * 128) = w; } } }
    }
};
}

namespace att {
constexpr int D = 128, NW = 8, QBLK = 32, KVBLK = 64;
constexpr float SCALE = 0.088388347648318440f;
constexpr float THR = 8.f;
constexpr int LDQ = AW, LDK = KVW, LDO = DM;
constexpr size_t SHM_V = KVBLK * D * 2, SHM_K = KVBLK * D * 2, SHM_ATTN = 2 * SHM_V + 2 * SHM_K + NW * 64 * 4;
#define KSWZ(row, colB) ((row) * 256 + ((colB) ^ (((row) & 7) << 4)))
#define SBAR() __builtin_amdgcn_sched_barrier(0)
__device__ __forceinline__ int crow(int r, int hi) { return (r & 3) + 8 * (r >> 2) + 4 * hi; }
__device__ __forceinline__ unsigned cvtpk(float lo, float hi) { unsigned r; asm volatile("v_cvt_pk_bf16_f32 %0, %1, %2" : "=v"(r) : "v"(lo), "v"(hi)); return r; }
__device__ __forceinline__ void partialSM(f32x16& p0, f32x16& p1, float& m_reg, float& mn, float& alpha) {
  constexpr float C = SCALE * 1.4426950408889634f;
  float pmax = p0[0]; for (int r = 1; r < 16; ++r) pmax = fmaxf(pmax, p0[r]); for (int r = 0; r < 16; ++r) pmax = fmaxf(pmax, p1[r]);
  { auto rr = __builtin_amdgcn_permlane32_swap(__float_as_uint(pmax), __float_as_uint(pmax), false, false);
    pmax = fmaxf(__uint_as_float(rr[0]), __uint_as_float(rr[1])); }
  if (__builtin_expect(__all(pmax - m_reg <= THR / SCALE), 1)) { mn = m_reg; alpha = 1.f; }
  else { mn = fmaxf(m_reg, pmax); alpha = __builtin_amdgcn_exp2f((m_reg - mn) * C); m_reg = mn; }
  float mnC = -mn * C;
  for (int r = 0; r < 16; ++r) p0[r] = fmaf(p0[r], C, mnC); for (int r = 0; r < 16; ++r) p1[r] = fmaf(p1[r], C, mnC);
  for (int r = 0; r < 16; ++r) p0[r] = __builtin_amdgcn_exp2f(p0[r]);
}
__device__ __forceinline__ void finishSM(f32x16& p0, f32x16& p1, float alpha, float& l_reg, bf16x8& pa0, bf16x8& pa1, bf16x8& pa2, bf16x8& pa3) {
  for (int r = 0; r < 16; ++r) p1[r] = __builtin_amdgcn_exp2f(p1[r]);
  float ps = 0; for (int r = 0; r < 16; ++r) ps += p0[r]; for (int r = 0; r < 16; ++r) ps += p1[r];
  { auto rr = __builtin_amdgcn_permlane32_swap(__float_as_uint(ps), __float_as_uint(ps), false, false);
    ps = __uint_as_float(rr[0]) + __uint_as_float(rr[1]); }
  l_reg = l_reg * alpha + ps;
#define PK4(P, BASE, OUT) do { unsigned a0 = cvtpk(P[BASE + 0], P[BASE + 1]), a1 = cvtpk(P[BASE + 2], P[BASE + 3]);   \
    unsigned b0 = cvtpk(P[BASE + 4], P[BASE + 5]), b1 = cvtpk(P[BASE + 6], P[BASE + 7]);                              \
    auto r0 = __builtin_amdgcn_permlane32_swap(a0, b0, false, false); auto r1 = __builtin_amdgcn_permlane32_swap(a1, b1, false, false); \
    u32x4 w = {r0[0], r1[0], r0[1], r1[1]}; OUT = *reinterpret_cast<bf16x8*>(&w); } while (0)
  PK4(p0, 0, pa0); PK4(p0, 8, pa1); PK4(p1, 0, pa2); PK4(p1, 8, pa3);
#undef PK4
}
__device__ __forceinline__ void qkt(f32x16& p0, f32x16& p1, const bf16_t* Ks, const bf16x8* qr, int r32, int hi) {
  p0 = f32x16{}; p1 = f32x16{};
  for (int d0 = 0; d0 < 8; ++d0) { int cb = (d0 * 16 + hi * 8) * 2;
    bf16x8 b0 = *reinterpret_cast<const bf16x8*>((const char*)Ks + KSWZ(r32, cb));
    bf16x8 b1 = *reinterpret_cast<const bf16x8*>((const char*)Ks + KSWZ(32 + r32, cb));
    p0 = __builtin_amdgcn_mfma_f32_32x32x16_bf16(b0, qr[d0], p0, 0, 0, 0);
    p1 = __builtin_amdgcn_mfma_f32_32x32x16_bf16(b1, qr[d0], p1, 0, 0, 0); }
}
__device__ __forceinline__ int v_st(int k, int c) { const int kk = (k & ~0xC) | ((k & 4) << 1) | ((k & 8) >> 1); return ((kk >> 3) * 4 + (c >> 5)) * 512 + ((kk & 7) * 32 + (c & 31)) * 2; }
__device__ __forceinline__ int v_rd_base(int lane) { return ((lane & 3) << 3) | (((lane >> 2) & 3) << 6) | (((lane >> 4) & 1) << 5) | (((lane >> 5) & 1) << 8); }
constexpr int v_rd_off(int d0, int ks, int half) { return d0 * 512 + ks * 4096 + half * 2048; }
template <int OFF> __device__ __forceinline__ s16x4 tr_read(int vb) {
  s16x4 r; asm volatile("ds_read_b64_tr_b16 %0, %1 offset:%2" : "=&v"(r) : "v"(vb), "i"(OFF) : "memory"); return r;
}
template <int D0> __device__ __forceinline__ void pv_one(f32x16& od, int vb, bf16x8 pa0, bf16x8 pa1, bf16x8 pa2, bf16x8 pa3) {
  const s16x4 l0 = tr_read<v_rd_off(D0, 0, 0)>(vb), h0 = tr_read<v_rd_off(D0, 0, 1)>(vb), l1 = tr_read<v_rd_off(D0, 1, 0)>(vb), h1 = tr_read<v_rd_off(D0, 1, 1)>(vb);
  const s16x4 l2 = tr_read<v_rd_off(D0, 2, 0)>(vb), h2 = tr_read<v_rd_off(D0, 2, 1)>(vb), l3 = tr_read<v_rd_off(D0, 3, 0)>(vb), h3 = tr_read<v_rd_off(D0, 3, 1)>(vb);
  asm volatile("s_waitcnt lgkmcnt(0)" ::: "memory"); SBAR();
#define PK(L, H) (bf16x8){L[0], L[1], L[2], L[3], H[0], H[1], H[2], H[3]}
  od = __builtin_amdgcn_mfma_f32_32x32x16_bf16(pa0, PK(l0, h0), od, 0, 0, 0);
  od = __builtin_amdgcn_mfma_f32_32x32x16_bf16(pa1, PK(l1, h1), od, 0, 0, 0);
  od = __builtin_amdgcn_mfma_f32_32x32x16_bf16(pa2, PK(l2, h2), od, 0, 0, 0);
  od = __builtin_amdgcn_mfma_f32_32x32x16_bf16(pa3, PK(l3, h3), od, 0, 0, 0);
#undef PK
}
__device__ __forceinline__ void pv_d0(f32x16* o, int vb, bf16x8 pa0, bf16x8 pa1, bf16x8 pa2, bf16x8 pa3) {
  pv_one<0>(o[0], vb, pa0, pa1, pa2, pa3); pv_one<1>(o[1], vb, pa0, pa1, pa2, pa3); pv_one<2>(o[2], vb, pa0, pa1, pa2, pa3); pv_one<3>(o[3], vb, pa0, pa1, pa2, pa3);
}
__device__ __forceinline__ void attn_dense_body(const bf16_t* __restrict__ Qb, const bf16_t* __restrict__ Kh, const bf16_t* __restrict__ Vh,
                                                bf16_t* __restrict__ Ob, float* __restrict__ ssq, int seq, char* lds) {
  int tid = threadIdx.x; asm volatile("" : "+v"(tid));
  const int wid = tid >> 6, lane = tid & 63, r32 = lane & 31, hi = lane >> 5;
  bf16_t* V_lds = (bf16_t*)lds; bf16_t* K_lds = (bf16_t*)(lds + 2 * SHM_V);
  float* ws = (float*)(lds + 2 * SHM_V + 2 * SHM_K) + wid * 64; float* li_l = ws; float* al_l = ws + 32;
  float m_reg = -1e30f, l_reg = 0; f32x16 o[4] = {}; bf16x8 qr[8];
  const bf16_t* Qw = Qb + (long)(wid * QBLK + r32) * LDQ + hi * 8;
#pragma unroll
  for (int d0 = 0; d0 < 8; ++d0) qr[d0] = *reinterpret_cast<const bf16x8*>(Qw + d0 * 16);
  const int sr = tid >> 4, sc = (tid & 15) * 8, vst0 = v_st(sr, sc), vst1 = v_st(32 + sr, sc);
  const int vb0 = (int)(uintptr_t)V_lds + v_rd_base(lane);
  struct { bf16x8 vs0, vs1, ks0, ks1; } sr_[2];
#define SLOAD(i, k0) do { sr_[i].vs0 = *reinterpret_cast<const bf16x8*>(&Vh[(long)((k0) + sr) * LDK + sc]); sr_[i].vs1 = *reinterpret_cast<const bf16x8*>(&Vh[(long)((k0) + 32 + sr) * LDK + sc]); \
    sr_[i].ks0 = *reinterpret_cast<const bf16x8*>(&Kh[(long)((k0) + sr) * LDK + sc]); sr_[i].ks1 = *reinterpret_cast<const bf16x8*>(&Kh[(long)((k0) + 32 + sr) * LDK + sc]); } while (0)
#define SWRITE(b, i) do { *(bf16x8*)((char*)V_lds + (b) * SHM_V + vst0) = sr_[i].vs0;          \
    *(bf16x8*)((char*)V_lds + (b) * SHM_V + vst1) = sr_[i].vs1; int kc = sc * 2;               \
    *(bf16x8*)((char*)K_lds + (b) * SHM_K + KSWZ(sr, kc)) = sr_[i].ks0;                       \
    *(bf16x8*)((char*)K_lds + (b) * SHM_K + KSWZ(32 + sr, kc)) = sr_[i].ks1; } while (0)
#define SWAIT() asm volatile("s_waitcnt vmcnt(4)" ::: "memory")
#define RESC(a) do { if (__any((a) < 1.f)) { if (hi == 0) al_l[r32] = (a); asm volatile("s_waitcnt lgkmcnt(0)" ::: "memory"); \
    for (int d = 0; d < 4; ++d) for (int r = 0; r < 16; ++r) o[d][r] *= al_l[crow(r, hi)]; } } while (0)
  f32x16 pA0, pA1, pB0, pB1; float mnA, mnB, alA, alB; bf16x8 pa0, pa1, pa2, pa3; const int NT = seq / KVBLK;
  constexpr int SE = 0, SO = 1;
  SLOAD(SE, 0); asm volatile("s_waitcnt vmcnt(0)" ::: "memory"); SWRITE(0, SE); __syncthreads();
  qkt(pA0, pA1, K_lds, qr, r32, hi); partialSM(pA0, pA1, m_reg, mnA, alA);
  SLOAD(SO, KVBLK); if (2 < NT) SLOAD(SE, 2 * KVBLK);
  SWAIT(); SWRITE(1, SO); __syncthreads();
  for (int j = 1; j + 1 < NT; j += 2) {
    SBAR(); qkt(pB0, pB1, (bf16_t*)((char*)K_lds + SHM_K), qr, r32, hi);
    finishSM(pA0, pA1, alA, l_reg, pa0, pa1, pa2, pa3); SBAR();
    SLOAD(SO, (j + 2) * KVBLK); SBAR();
    pv_d0(o, vb0, pa0, pa1, pa2, pa3); partialSM(pB0, pB1, m_reg, mnB, alB);
    __syncthreads(); SWAIT(); SWRITE(0, SE);
    RESC(alB); __syncthreads();
    SBAR(); qkt(pA0, pA1, K_lds, qr, r32, hi);
    finishSM(pB0, pB1, alB, l_reg, pa0, pa1, pa2, pa3); SBAR();
    if (j + 3 < NT) SLOAD(SE, (j + 3) * KVBLK); SBAR();
    pv_d0(o, vb0 + (int)SHM_V, pa0, pa1, pa2, pa3); partialSM(pA0, pA1, m_reg, mnA, alA);
    __syncthreads(); SWAIT(); SWRITE(1, SO);
    RESC(alA); __syncthreads();
  }
  SBAR(); qkt(pB0, pB1, (bf16_t*)((char*)K_lds + SHM_K), qr, r32, hi);
  finishSM(pA0, pA1, alA, l_reg, pa0, pa1, pa2, pa3); SBAR();
  pv_d0(o, vb0, pa0, pa1, pa2, pa3); partialSM(pB0, pB1, m_reg, mnB, alB);
  __syncthreads(); RESC(alB);
  finishSM(pB0, pB1, alB, l_reg, pa0, pa1, pa2, pa3); SBAR();
  pv_d0(o, vb0 + (int)SHM_V, pa0, pa1, pa2, pa3);
  if (hi == 0) li_l[r32] = l_reg; asm volatile("s_waitcnt lgkmcnt(0)" ::: "memory");
  float rli[16];
#pragma unroll
  for (int r = 0; r < 16; ++r) rli[r] = __builtin_amdgcn_rcpf(li_l[crow(r, hi)]);
  int r32e = r32, hie = hi; asm volatile("" : "+v"(r32e), "+v"(hie));
  bf16_t* Ow = Ob + (long)(wid * QBLK) * LDO;
#pragma unroll
  for (int r = 0; r < 16; ++r) { const int orow = crow(r, hie); float ss = 0.f;
#pragma unroll
    for (int d0 = 0; d0 < 4; ++d0) { const float v = o[d0][r] * rli[r]; ss += v * v; Ow[(long)orow * LDO + d0 * 32 + r32e] = (bf16_t)(cvtpk(v, v) & 0xffffu); }
    ss += __shfl_xor(ss, 1); ss += __shfl_xor(ss, 2); ss += __shfl_xor(ss, 4); ss += __shfl_xor(ss, 8); ss += __shfl_xor(ss, 16);
    if (r32e == 0) ssq[(long)(wid * QBLK + orow) * 8] = ss; }
  __syncthreads();
#undef SLOAD
#undef SWRITE
#undef SWAIT
#undef RESC
}
#undef KSWZ
#undef SBAR
}

#define XB_TMO      128
#define XB_XCNT(j)  (256  + 64 * (j))
#define XB_XSUB(j)  (1280 + 64 * (j))
#define XB_XGEN(j)  (2304 + 64 * (j))
#define XB_TOP      3328
#define XB_TOPGEN   3392
#define XCD_BAR_WORDS 3456
#define XB_SPIN_CAP (1u << 18)
__device__ __forceinline__ unsigned xb_ld(unsigned* p)              { return __hip_atomic_load(p, __ATOMIC_RELAXED, __HIP_MEMORY_SCOPE_AGENT); }
__device__ __forceinline__ unsigned xb_add(unsigned* p, unsigned v) { return __hip_atomic_fetch_add(p, v, __ATOMIC_RELAXED, __HIP_MEMORY_SCOPE_AGENT); }
__device__ __forceinline__ unsigned xb_xcc_id() { return (unsigned)__builtin_amdgcn_s_getreg((3 << 11) | 20) & 0xFu; }
#define XB_SPIN(cond, bar) do { unsigned _sp = 0; while (cond) { __builtin_amdgcn_s_sleep(1); \
    if ((++_sp & 255u) == 0u) { if (xb_ld(&(bar)[XB_TMO])) break; if (_sp > XB_SPIN_CAP) { atomicAdd(&(bar)[XB_TMO], 1u); break; } } } } while (0)
struct XcdBarrier { unsigned* bar; unsigned x; volatile LAS unsigned* st; };
__device__ __forceinline__ XcdBarrier xcd_barrier_post(unsigned* bar, volatile LAS unsigned* st) {
    XcdBarrier b; b.bar = bar; b.x = xb_xcc_id(); b.st = st;
    if (threadIdx.x == 0) (void)xb_add(&bar[XB_XCNT(b.x)], 1u);
    return b;
}
__device__ __forceinline__ void xcd_barrier_complete(unsigned* bar, unsigned x, unsigned& nloc, unsigned& nx) {
    const unsigned G = gridDim.x * gridDim.y * gridDim.z;
    unsigned sum, cnt, mine, sp = 0u;
    for (;;) {
        sum = 0u; cnt = 0u; mine = 0u;
#pragma unroll
        for (unsigned j = 0; j < 16; ++j) { const unsigned c = xb_ld(&bar[XB_XCNT(j)]); sum += c; cnt += (c > 0u) ? 1u : 0u; mine = (j == x) ? c : mine; }
        if (sum == G) break;
        __builtin_amdgcn_s_sleep(1);
        if ((++sp & 255u) == 0u) { if (xb_ld(&bar[XB_TMO])) break; if (sp > XB_SPIN_CAP) { atomicAdd(&bar[XB_TMO], 1u); break; } }
    }
    nloc = mine > 0u ? mine : 1u; nx = cnt > 0u ? cnt : 1u;
}
__device__ __forceinline__ void xcd_barrier(const XcdBarrier& b) {
    asm volatile("s_waitcnt vmcnt(0)" ::: "memory");
    __syncthreads();
    if (threadIdx.x == 0) {
        unsigned* bar = b.bar;
        __builtin_amdgcn_s_waitcnt(0);
        unsigned nloc = b.st[0], nx = b.st[1];
        if (nloc == 0u) { xcd_barrier_complete(bar, b.x, nloc, nx); b.st[0] = nloc; b.st[1] = nx; }
        const unsigned old = xb_add(&bar[XB_XSUB(b.x)], 1u);
        const unsigned gen = old / nloc;
        if (old + 1u == (gen + 1u) * nloc) {
            __builtin_amdgcn_fence(__ATOMIC_RELEASE, "agent");
            asm volatile("s_waitcnt vmcnt(0)" ::: "memory");
            const unsigned og = xb_add(&bar[XB_TOP], 1u);
            const unsigned tg = og / nx;
            if (og + 1u == (tg + 1u) * nx) xb_add(&bar[XB_TOPGEN], 1u);
            else XB_SPIN(xb_ld(&bar[XB_TOPGEN]) == tg, bar);
            __builtin_amdgcn_fence(__ATOMIC_ACQUIRE, "agent");
            xb_add(&bar[XB_XGEN(b.x)], 1u);
            asm volatile("s_waitcnt vmcnt(0)" ::: "memory");
        } else {
            XB_SPIN(xb_ld(&bar[XB_XGEN(b.x)]) == gen, bar);
            __builtin_amdgcn_fence(__ATOMIC_ACQUIRE, "agent");
            asm volatile("s_waitcnt vmcnt(0)" ::: "memory");
        }
    }
    __syncthreads();
}

struct Args { const float* in[34]; float* out; unsigned char* ws; int ph_lo, ph_hi; };
enum { I_X = 0, I_P, I_LN0G, I_LN0B, I_WIN, I_QG, I_KG, I_ARE, I_AIM, I_LDT, I_BRE, I_BIM, I_CRE, I_CIM, I_SD, I_WGLU, I_BGLU, I_AOG, I_SOG, I_WOUT,
       I_LN1G, I_LN1B, I_RGW, I_RGB, I_REW, I_REB, I_WG, I_WU, I_WD, I_WPLE, I_WPG, I_BPG, I_LN2G, I_LN2B };

typedef const Args __attribute__((address_space(4)))* KArgP;
__device__ __forceinline__ KArgP kargs() { KArgP p = (KArgP)__builtin_amdgcn_kernarg_segment_ptr(); asm volatile("" : "+s"(p)); return p; }
struct Frame {
    LAS unsigned char* lds; unsigned char* ws; unsigned* ctl;
    int tid, lane, wave, vcu, G, bx;
};

struct TrDesc { const float* W; bf16_t* WT; const float* ks; int K, N, rmode, k0, n0; };
__device__ __forceinline__ void tr_load(const TrDesc& d, f32x4 (&v)[16], int lane) {
    const int lr = lane >> 4, lc = (lane & 15) * 4; const float* p = d.W + (size_t)(d.k0 + lr) * d.N + d.n0 + lc; const size_t st = (size_t)4 * d.N;
#pragma unroll
    for (int i = 0; i < 16; ++i) v[i] = __builtin_nontemporal_load((const f32x4*)(p + i * st));
}
__device__ __forceinline__ void tr_store(const TrDesc& d, const f32x4 (&v)[16], LAS float* scr, int lane) {
    const int lr = lane >> 4, lc = (lane & 15) * 4;
#pragma unroll
    for (int i = 0; i < 16; ++i) { const int kk = 4 * i + lr; f32x4 x = v[i]; if (d.ks) x = x * d.ks[d.k0 + kk];
        scr[kk * 65 + lc + 0] = x[0]; scr[kk * 65 + lc + 1] = x[1]; scr[kk * 65 + lc + 2] = x[2]; scr[kk * 65 + lc + 3] = x[3]; }
    LDS_WAIT(); asm volatile("" ::: "memory");
    const int c = lane & 7;
#pragma unroll
    for (int j = 0; j < 8; ++j) { const int n = (lane >> 3) + 8 * j; const LAS float* s = scr + (8 * c) * 65 + n;
        u32x4 o; o.x = cvt_pk_bf16(s[0 * 65], s[1 * 65]); o.y = cvt_pk_bf16(s[2 * 65], s[3 * 65]); o.z = cvt_pk_bf16(s[4 * 65], s[5 * 65]); o.w = cvt_pk_bf16(s[6 * 65], s[7 * 65]);
        const int ng = d.n0 + n; const int dr = d.rmode == 0 ? ng : ((ng >> 7) * 256 + (ng & 127) + (d.rmode == 2 ? 128 : 0));
        __builtin_nontemporal_store(o, (u32x4*)(d.WT + (size_t)dr * d.K + d.k0 + 8 * c)); }
    LDS_WAIT(); asm volatile("" ::: "memory");
}
__device__ __forceinline__ void ln_row(f32x4 (&v)[8], const float* __restrict__ g, const float* __restrict__ b, int lane) {
    float s = 0.f;
#pragma unroll
    for (int i = 0; i < 8; ++i) s += (v[i][0] + v[i][1]) + (v[i][2] + v[i][3]);
    const float mean = wave_sum(s) * (1.f / DM); float s2 = 0.f;
#pragma unroll
    for (int i = 0; i < 8; ++i) { v[i] = v[i] - mean; s2 += (v[i][0] * v[i][0] + v[i][1] * v[i][1]) + (v[i][2] * v[i][2] + v[i][3] * v[i][3]); }
    const float rstd = rsqrtf(wave_sum(s2) * (1.f / DM) + EPS);
#pragma unroll
    for (int i = 0; i < 8; ++i) { const f32x4 gg = *(const f32x4*)(g + 4 * lane + 256 * i), bb = *(const f32x4*)(b + 4 * lane + 256 * i); v[i] = v[i] * rstd * gg + bb; }
}
__device__ __forceinline__ void store_row(const f32x4 (&v)[8], float* xf, bf16_t* xb, int lane) {
#pragma unroll
    for (int i = 0; i < 8; ++i) { if (xf) *(f32x4*)(xf + 4 * lane + 256 * i) = v[i];
        if (xb) { u32x2 w; w.x = cvt_pk_bf16(v[i][0], v[i][1]); w.y = cvt_pk_bf16(v[i][2], v[i][3]); *(u32x2*)(xb + 4 * lane + 256 * i) = w; } }
}

__device__ __forceinline__ void ssm_build(KArgP a, Frame& F, int l, int g) {
    LAS float* L = (LAS float*)F.lds;
    LAS float* APr = L;
    LAS float* APi = L + 2176;
    LAS float* BBr = L + 4352;
    LAS float* BBi = L + 6400;
    LAS float* Cr = L + 8448;
    LAS float* Ci = L + 10496;
    LAS float* KT = L + 12544;
    const int tid = F.tid;
    LAS float* COr = L + 20736; LAS float* COi = L + 20864;
    if (tid < 128) { const int d = tid >> 6, p = tid & 63; const size_t pi = ((size_t)(l * 2 + d) * NG + g) * NP + p; const float dt = expf(a->in[I_LDT][(l * 2 + d) * NG + g]);
        const float ar = a->in[I_ARE][pi], ai = a->in[I_AIM][pi], zr = dt * ar, zi = dt * ai; const float mg = expf(zr), cz = cosf(zi), sz = sinf(zi);
        const float abr = mg * cz, abi = mg * sz;
        const float sh = sinf(0.5f * zi); const float nr = expm1f(zr) * cz - 2.f * sh * sh, ni = abi;
        const float den = ar * ar + ai * ai; COr[tid] = (nr * ar + ni * ai) / den; COi[tid] = (ni * ar - nr * ai) / den;
        float pr = 1.f, pim = 0.f;
        for (int e = 0; e < 17; ++e) { APr[(d * 17 + e) * 64 + p] = pr; APi[(d * 17 + e) * 64 + p] = pim; const float t = pr * abr - pim * abi; pim = pr * abi + pim * abr; pr = t; } }
    for (int i = tid; i < 2 * 16 * 64; i += 512) { const int d = i >> 10, r = i & 1023; const size_t ci_ = ((size_t)(l * 2 + d) * NG + g) * (NH * NP) + r;
        Cr[i] = a->in[I_CRE][ci_]; Ci[i] = a->in[I_CIM][ci_]; }
    LDS_WAIT(); __syncthreads();
    for (int i = tid; i < 2 * 64 * 16; i += 512) { const int d = i >> 10, r = i & 1023, p = r >> 4, h = r & 15;
        const size_t pi = ((size_t)(l * 2 + d) * NG + g) * NP + p; const float cr = COr[d * 64 + p], ci = COi[d * 64 + p];
        const float br = a->in[I_BRE][pi * NH + h], bi = a->in[I_BIM][pi * NH + h];
        BBr[i] = cr * br - ci * bi; BBi[i] = cr * bi + ci * br; }
    LDS_WAIT(); __syncthreads();
    { const int d = tid >> 8, j = (tid >> 4) & 15, hp = tid & 15; float kacc[16];
#pragma unroll
      for (int h = 0; h < 16; ++h) kacc[h] = 0.f;
      for (int p = 0; p < 64; ++p) { const float xr = APr[(d * 17 + j) * 64 + p], xi = APi[(d * 17 + j) * 64 + p], br = BBr[(d * 64 + p) * 16 + hp], bi = BBi[(d * 64 + p) * 16 + hp];
          const float tr = xr * br - xi * bi, ti = xr * bi + xi * br;
#pragma unroll
          for (int h = 0; h < 16; ++h) kacc[h] += Cr[(d * 16 + h) * 64 + p] * tr - Ci[(d * 16 + h) * 64 + p] * ti; }
#pragma unroll
      for (int h = 0; h < 16; ++h) KT[((d * 16 + j) * 16 + h) * 16 + hp] = kacc[h]; }
    LDS_WAIT(); __syncthreads();
    bf16_t* W1 = (bf16_t*)(F.ws + WS_W + (size_t)l * WL_BYTES + WL_S1) + (size_t)g * 256 * 256;
    bf16_t* W2 = (bf16_t*)(F.ws + WS_W + (size_t)l * WL_BYTES + WL_S2) + (size_t)g * 256 * 512;
    const float* dsk = a->in[I_SD] + ((size_t)l * NG + g) * NH;
    for (int i = tid; i < 256 * 32; i += 512) { const int n = i >> 5, kc = i & 31, sg = kc >> 1, h0 = (kc & 1) * 8; const int d = n >> 7, ri = (n >> 6) & 1, p = n & 63;
        const int e = d == 0 ? 15 - sg : sg; const float xr = APr[(d * 17 + e) * 64 + p], xi = APi[(d * 17 + e) * 64 + p]; float o[8];
#pragma unroll
        for (int q = 0; q < 8; ++q) { const float br = BBr[(d * 64 + p) * 16 + h0 + q], bi = BBi[(d * 64 + p) * 16 + h0 + q]; o[q] = ri == 0 ? xr * br - xi * bi : xr * bi + xi * br; }
        u32x4 w; w.x = cvt_pk_bf16(o[0], o[1]); w.y = cvt_pk_bf16(o[2], o[3]); w.z = cvt_pk_bf16(o[4], o[5]); w.w = cvt_pk_bf16(o[6], o[7]);
        *(u32x4*)(W1 + (size_t)n * 256 + sg * 16 + h0) = w; }
    for (int i = tid; i < 256 * 64; i += 512) { const int n = i >> 6, kc = i & 63, tau = n >> 4, h = n & 15; float o[8];
        if (kc < 32) { const int sg = kc >> 1, h0 = (kc & 1) * 8;
#pragma unroll
            for (int q = 0; q < 8; ++q) { const int hp = h0 + q; float v;
                if (tau > sg) v = KT[((0 * 16 + (tau - sg)) * 16 + h) * 16 + hp];
                else if (sg > tau) v = KT[((1 * 16 + (sg - tau)) * 16 + h) * 16 + hp];
                else v = KT[((0 * 16 + 0) * 16 + h) * 16 + hp] + KT[((1 * 16 + 0) * 16 + h) * 16 + hp] + (hp == h ? dsk[h] : 0.f);
                o[q] = v; }
            u32x4 w; w.x = cvt_pk_bf16(o[0], o[1]); w.y = cvt_pk_bf16(o[2], o[3]); w.z = cvt_pk_bf16(o[4], o[5]); w.w = cvt_pk_bf16(o[6], o[7]);
            *(u32x4*)(W2 + (size_t)n * 512 + sg * 16 + h0) = w;
        } else { const int kk = (kc - 32) * 8, d = kk >> 7, ri = (kk >> 6) & 1, p0 = kk & 63; const int e = d == 0 ? tau + 1 : 16 - tau;
#pragma unroll
            for (int q = 0; q < 8; ++q) { const int p = p0 + q; const float xr = APr[(d * 17 + e) * 64 + p], xi = APi[(d * 17 + e) * 64 + p], cr = Cr[(d * 16 + h) * 64 + p], ci = Ci[(d * 16 + h) * 64 + p];
                o[q] = ri == 0 ? (cr * xr - ci * xi) : -(cr * xi + ci * xr); }
            u32x4 w; w.x = cvt_pk_bf16(o[0], o[1]); w.y = cvt_pk_bf16(o[2], o[3]); w.z = cvt_pk_bf16(o[4], o[5]); w.w = cvt_pk_bf16(o[6], o[7]);
            *(u32x4*)(W2 + (size_t)n * 512 + 256 + kk) = w; }
    }
    __syncthreads();
}

__device__ __forceinline__ void p0_prologue(KArgP a, Frame& F) {
#ifndef PROBE_DUP
#define PROBE_DUP 0
#endif
#define PREP(k) for (int prep_ = 0; prep_ < ((PROBE_DUP >> (k)) & 1) + 1; ++prep_)
    PREP(13) for (int it = F.vcu; it < NL * NG; it += F.G) ssm_build(a, F, it / NG, it % NG);
    __syncthreads();
    LAS float* scr = (LAS float*)(F.lds + F.wave * 16640);
    const int gw = F.vcu * NWAVES + F.wave, NGW = F.G * NWAVES;
    constexpr int I_IN = 32 * 40, I_GLU = 16 * 16, I_OUT = 32 * 32, I_G1 = 32 * 8, I_D1 = 8 * 32, I_PLE = 4 * 32, I_PG = 32 * 32;
    constexpr int PER_L = I_IN + I_GLU + I_OUT + 16 * I_G1 * 2 + 16 * I_D1 + I_PLE + I_PG;
    auto decode = [&](int it, TrDesc& d) {
        const int l = it / PER_L; int r = it - l * PER_L; unsigned char* wl = F.ws + WS_W + (size_t)l * WL_BYTES; d.ks = nullptr; d.rmode = 0;
        if (r < I_IN) { d.W = a->in[I_WIN] + (size_t)l * DM * DIN; d.K = DM; d.N = DIN; d.WT = (bf16_t*)(wl + WL_IN); }
        else if ((r -= I_IN) < I_GLU) { d.W = a->in[I_WGLU] + (size_t)l * SW * SW; d.K = SW; d.N = SW; d.WT = (bf16_t*)(wl + WL_GLU); }
        else if ((r -= I_GLU) < I_OUT) { d.W = a->in[I_WOUT] + (size_t)l * DM * DM; d.K = DM; d.N = DM; d.WT = (bf16_t*)(wl + WL_OUT); d.ks = (r % 32) < 16 ? a->in[I_AOG] + (size_t)l * AW : a->in[I_SOG] + (size_t)l * SW - AW; }
        else if ((r -= I_OUT) < 16 * I_G1) { const int e = r / I_G1; r -= e * I_G1; d.W = a->in[I_WG] + ((size_t)l * NE + e) * DM * DE; d.K = DM; d.N = DE; d.WT = (bf16_t*)(wl + WL_GU) + (size_t)e * 1024 * DM; d.rmode = 1; }
        else if ((r -= 16 * I_G1) < 16 * I_G1) { const int e = r / I_G1; r -= e * I_G1; d.W = a->in[I_WU] + ((size_t)l * NE + e) * DM * DE; d.K = DM; d.N = DE; d.WT = (bf16_t*)(wl + WL_GU) + (size_t)e * 1024 * DM; d.rmode = 2; }
        else if ((r -= 16 * I_G1) < 16 * I_D1) { const int e = r / I_D1; r -= e * I_D1; d.W = a->in[I_WD] + ((size_t)l * NE + e) * DE * DM; d.K = DE; d.N = DM; d.WT = (bf16_t*)(wl + WL_DN) + (size_t)e * DM * DE; }
        else if ((r -= 16 * I_D1) < I_PLE) { d.W = a->in[I_WPLE] + (size_t)l * PLE * DM; d.K = PLE; d.N = DM; d.WT = (bf16_t*)(wl + WL_PLE); }
        else { r -= I_PLE; d.W = a->in[I_WPG] + (size_t)l * DM * DM; d.K = DM; d.N = DM; d.WT = (bf16_t*)(wl + WL_PG); }
        const int kblk = d.K >> 6, nb = r / kblk; d.n0 = nb * 64; d.k0 = (r - nb * kblk) * 64;
    };
    PREP(14) {
        f32x4 va[16], vb[16]; TrDesc da, db; int it = gw;
        if (it < NL * PER_L) { decode(it, da); tr_load(da, va, F.lane); }
        while (it < NL * PER_L) {
            const int it1 = it + NGW; if (it1 < NL * PER_L) { decode(it1, db); tr_load(db, vb, F.lane); }
            tr_store(da, va, scr, F.lane);
            const int it2 = it1 + NGW; if (it1 >= NL * PER_L) break;
            if (it2 < NL * PER_L) { decode(it2, da); tr_load(da, va, F.lane); }
            tr_store(db, vb, scr, F.lane);
            it = it2;
        }
    }
    PREP(15) { const int gt = F.vcu * 512 + F.tid, NT = F.G * 512;
      for (int i = gt; i < NL * 65536; i += NT) { const int l = i >> 16, r = i & 65535;
          const int j = r & 7, ln = (r >> 3) & 63, nt = (r >> 9) & 1, sp = (r >> 10) & 7, w = (r >> 13) & 7, k = 256 * w + 32 * sp + 8 * (ln >> 4) + j, n = (ln & 15) + 16 * nt;
          const float v = n < 4 ? a->in[I_RGW][((size_t)l * DM + k) * 4 + n] : n < 20 ? a->in[I_REW][((size_t)l * DM + k) * 16 + (n - 4)] : 0.f;
          const unsigned hi = cvt_pk_bf16(v, v) & 0xffffu; const float rem = v - __uint_as_float(hi << 16); const unsigned lo = cvt_pk_bf16(rem, rem) & 0xffffu;
          bf16_t* dst = (bf16_t*)(F.ws + WS_W + (size_t)l * WL_BYTES + WL_RT);
          const size_t o = ((((size_t)(w * 8 + sp) * 2 + nt) * 2) * 64 + ln) * 8 + j;
          dst[o] = (bf16_t)hi; dst[o + 512] = (bf16_t)lo; }
      float* cosT = (float*)(F.ws + WS_TAB); float* sinT = cosT + SEQ * 64;
      for (int i = gt; i < SEQ * 64; i += NT) { const int t = i >> 6, ai = i & 63; const float pos = (float)(ai < 32 ? (t >> 6) : (t & 63));
          const float inv = powf(10000.0f, -(float)(ai & 31) / 32.0f); const float ang = pos * inv; cosT[i] = cosf(ang); sinT[i] = sinf(ang); }
      const float* p = a->in[I_P]; bf16_t* pb = (bf16_t*)(F.ws + WS_PB);
      for (size_t i = (size_t)gt; i < (size_t)NL * T * PLE / 8; i += NT) { const f32x4 x0 = *(const f32x4*)(p + i * 8), x1 = *(const f32x4*)(p + i * 8 + 4); u32x4 w;
          w.x = cvt_pk_bf16(x0[0], x0[1]); w.y = cvt_pk_bf16(x0[2], x0[3]); w.z = cvt_pk_bf16(x1[0], x1[1]); w.w = cvt_pk_bf16(x1[2], x1[3]); *(u32x4*)(pb + i * 8) = w; }
    }
    bf16_t* XB = (bf16_t*)(F.ws + WS_XB);
    PREP(16) for (int m = gw; m < T; m += NGW) { f32x4 v[8];
#pragma unroll
        for (int i = 0; i < 8; ++i) v[i] = *(const f32x4*)(a->in[I_X] + (size_t)m * DM + 4 * F.lane + 256 * i);
        ln_row(v, a->in[I_LN0G], a->in[I_LN0B], F.lane); store_row(v, nullptr, XB + (size_t)m * DM, F.lane); }
}

constexpr int RT_PITCH = 4112, RT_XL = 16 * RT_PITCH, RT_PART = 0, RT_LOG = 16384, RT_ENT = LX_P + 1024;
__device__ __forceinline__ void ph_ln1(KArgP a, Frame& F, int l, bool dummy) {
    bf16_t* XB = (bf16_t*)(F.ws + (dummy ? WS_Q : WS_XB)); const bf16_t* XBI = (const bf16_t*)(F.ws + WS_XB); const bf16_t* MB = (const bf16_t*)(F.ws + WS_FP);
    const float* g = a->in[I_LN1G] + (size_t)l * DM; const float* b = a->in[I_LN1B] + (size_t)l * DM;
    const bf16x8* wimg = (const bf16x8*)(F.ws + WS_W + (size_t)l * WL_BYTES + WL_RT);
    unsigned* ltok = dummy ? (unsigned*)(F.ws + WS_SS) : (unsigned*)(F.ws + WS_LT) + (size_t)l * NE * 8192; float* lgate = dummy ? (float*)(F.ws + WS_SS + 4 * MiB) : (float*)(F.ws + WS_LG) + (size_t)l * NE * 8192;
    unsigned* cnt = F.ctl + CW_CNT + (dummy ? l + 4 : l) * 16 * 64;
    LAS int* ENT_E = (LAS int*)(F.lds + RT_ENT); LAS unsigned* ENT_T = (LAS unsigned*)(F.lds + RT_ENT + 256); LAS float* ENT_G = (LAS float*)(F.lds + RT_ENT + 512);
    LAS float* PART = (LAS float*)(F.lds + RT_PART); LAS float* LOG = (LAS float*)(F.lds + RT_LOG);
    for (int blk = F.vcu; blk * 32 < T; blk += F.G) {
#pragma unroll 1
        for (int rnd = 0; rnd < 2; ++rnd) {
            __syncthreads();
#pragma unroll
            for (int r = 0; r < 2; ++r) {
                const int lr = F.wave * 2 + r, row = blk * 32 + rnd * 16 + lr; f32x4 x[8];
#pragma unroll
                for (int i = 0; i < 8; ++i) { const size_t o = (size_t)row * DM + 4 * F.lane + 256 * i; const u32x2 xw = *(const u32x2*)(XBI + o); const u32x2 mw = *(const u32x2*)(MB + o);
                    x[i][0] = bf_lo(xw.x) * ALPHA + bf_lo(mw.x); x[i][1] = bf_hi(xw.x) * ALPHA + bf_hi(mw.x); x[i][2] = bf_lo(xw.y) * ALPHA + bf_lo(mw.y); x[i][3] = bf_hi(xw.y) * ALPHA + bf_hi(mw.y); }
                ln_row(x, g, b, F.lane); store_row(x, nullptr, XB + (size_t)(dummy ? row & (T / 4 - 1) : row) * DM, F.lane);
#pragma unroll
                for (int i = 0; i < 8; ++i) { u32x2 hi; hi.x = cvt_pk_bf16(x[i][0], x[i][1]); hi.y = cvt_pk_bf16(x[i][2], x[i][3]);
                    const float r0 = x[i][0] - bf_lo(hi.x), r1 = x[i][1] - bf_hi(hi.x), r2 = x[i][2] - bf_lo(hi.y), r3 = x[i][3] - bf_hi(hi.y);
                    u32x2 lo; lo.x = cvt_pk_bf16(r0, r1); lo.y = cvt_pk_bf16(r2, r3);
                    const int off = lr * RT_PITCH + (4 * F.lane + 256 * i) * 2;
                    *(LAS u32x2*)(F.lds + off) = hi; *(LAS u32x2*)(F.lds + RT_XL + off) = lo; }
            }
            LDS_WAIT(); __syncthreads();
            f32x4 acc0 = {0.f, 0.f, 0.f, 0.f}, acc1 = {0.f, 0.f, 0.f, 0.f};
            {
                const int aoff = (F.lane & 15) * RT_PITCH + (256 * F.wave + 8 * (F.lane >> 4)) * 2;
#pragma unroll
                for (int sp = 0; sp < 8; ++sp) {
                    const bf16x8 ah = *(const LAS bf16x8*)(F.lds + aoff + sp * 64), al = *(const LAS bf16x8*)(F.lds + RT_XL + aoff + sp * 64);
                    const bf16x8* wp = wimg + ((size_t)(F.wave * 8 + sp) * 4) * 64 + F.lane;
                    const bf16x8 b0h = wp[0], b0l = wp[64], b1h = wp[128], b1l = wp[192];
                    acc0 = __builtin_amdgcn_mfma_f32_16x16x32_bf16(ah, b0h, acc0, 0, 0, 0); acc0 = __builtin_amdgcn_mfma_f32_16x16x32_bf16(al, b0h, acc0, 0, 0, 0); acc0 = __builtin_amdgcn_mfma_f32_16x16x32_bf16(ah, b0l, acc0, 0, 0, 0);
                    acc1 = __builtin_amdgcn_mfma_f32_16x16x32_bf16(ah, b1h, acc1, 0, 0, 0); acc1 = __builtin_amdgcn_mfma_f32_16x16x32_bf16(al, b1h, acc1, 0, 0, 0); acc1 = __builtin_amdgcn_mfma_f32_16x16x32_bf16(ah, b1l, acc1, 0, 0, 0);
                }
            }
            __syncthreads();
#pragma unroll
            for (int q = 0; q < 4; ++q) { const int prow = 4 * (F.lane >> 4) + q, pcol = F.lane & 15;
                PART[(F.wave * 16 + prow) * 32 + pcol] = acc0[q]; PART[(F.wave * 16 + prow) * 32 + 16 + pcol] = acc1[q]; }
            LDS_WAIT(); __syncthreads();
            { const int prow = F.tid >> 5, pcol = F.tid & 31; float sum = 0.f;
#pragma unroll
              for (int w = 0; w < 8; ++w) sum += PART[(w * 16 + prow) * 32 + pcol];
              const float bj = pcol < 4 ? a->in[I_RGB][l * 4 + pcol] : pcol < 20 ? a->in[I_REB][l * 16 + (pcol - 4)] : 0.f;
              LOG[prow * 32 + pcol] = sum + bj; }
            LDS_WAIT(); __syncthreads();
            if (F.tid < 16) {
                float lg[20];
#pragma unroll
                for (int j = 0; j < 20; ++j) lg[j] = LOG[F.tid * 32 + j];
                int gi = 0; float gm = lg[0];
#pragma unroll
                for (int j = 1; j < 4; ++j) if (lg[j] > gm) { gm = lg[j]; gi = j; }
                float gs = 0.f;
#pragma unroll
                for (int j = 0; j < 4; ++j) gs += expf(lg[j] - gm);
                const float gtop = 1.0f / gs;
                float sel[4];
#pragma unroll
                for (int j = 0; j < 4; ++j) sel[j] = gi == 0 ? lg[4 + j] : gi == 1 ? lg[8 + j] : gi == 2 ? lg[12 + j] : lg[16 + j];
                int i1 = 0; float m1 = sel[0];
#pragma unroll
                for (int j = 1; j < 4; ++j) if (sel[j] > m1) { m1 = sel[j]; i1 = j; }
                int i2 = (i1 == 0) ? 1 : 0; float m2 = sel[i1 == 0 ? 1 : 0];
#pragma unroll
                for (int j = 0; j < 4; ++j) if (j != i1 && sel[j] > m2) { m2 = sel[j]; i2 = j; }
                const float e2 = expf(m2 - m1); const float w1 = gtop / (1.0f + e2), w2 = gtop * e2 / (1.0f + e2);
                const int q = (rnd * 16 + F.tid) * 2; const unsigned tok = (unsigned)(blk * 32 + rnd * 16 + F.tid);
                ENT_E[q] = gi * 4 + i1; ENT_T[q] = tok; ENT_G[q] = w1; ENT_E[q + 1] = gi * 4 + i2; ENT_T[q + 1] = tok | 0x10000u; ENT_G[q + 1] = w2;
            }
        }
        LDS_WAIT(); __syncthreads();
        if (F.wave == 0) {
            const int e = ENT_E[F.lane]; const unsigned tk = ENT_T[F.lane]; const float gt = ENT_G[F.lane];
            int rank = 0, mycnt = 0;
#pragma unroll
            for (int k = 0; k < 16; ++k) { const unsigned long long m = __ballot(e == k); if (e == k) rank = __popcll(m & ((1ull << F.lane) - 1ull)); if (F.lane == k) mycnt = __popcll(m); }
            unsigned bse = 0u; if (F.lane < 16 && mycnt > 0) bse = __hip_atomic_fetch_add(cnt + F.lane * 64, (unsigned)mycnt, RLX_AGENT);
            const unsigned pos = (unsigned)__shfl((int)bse, e) + (unsigned)rank;
            ltok[e * 8192 + pos] = tk; lgate[e * 8192 + pos] = gt;
        }
    }
    __syncthreads();
}
__device__ __forceinline__ void ph_comb(KArgP a, Frame& F, int l, bool dummy) {
    float* XF = (float*)(F.ws + WS_XF); bf16_t* XB = (bf16_t*)(F.ws + (dummy ? WS_Q : WS_XB)); const bf16_t* XBI = (const bf16_t*)(F.ws + WS_XB); const bf16_t* PE = (const bf16_t*)(F.ws + WS_UX); (void)XF; const bf16_t* FP = (const bf16_t*)(F.ws + WS_FP);
    const float* g = a->in[I_LN2G] + (size_t)l * DM; const float* b = a->in[I_LN2B] + (size_t)l * DM;
    const int gw = F.vcu * NWAVES + F.wave, NGW = F.G * NWAVES;
    for (int m = gw; m < T; m += NGW) { f32x4 v[8];
#pragma unroll
        for (int i = 0; i < 8; ++i) { const int c = 4 * F.lane + 256 * i; const u32x2 xw = *(const u32x2*)(XBI + (size_t)m * DM + c); const f32x4 x = {bf_lo(xw.x), bf_hi(xw.x), bf_lo(xw.y), bf_hi(xw.y)};
            const u32x2 f0 = *(const u32x2*)(FP + ((size_t)m * 2) * DM + c), f1 = *(const u32x2*)(FP + ((size_t)m * 2 + 1) * DM + c), pe = *(const u32x2*)(PE + (size_t)m * DM + c);
            v[i][0] = (x[0] * ALPHA + bf_lo(pe.x)) + (bf_lo(f0.x) + bf_lo(f1.x)); v[i][1] = (x[1] * ALPHA + bf_hi(pe.x)) + (bf_hi(f0.x) + bf_hi(f1.x));
            v[i][2] = (x[2] * ALPHA + bf_lo(pe.y)) + (bf_lo(f0.y) + bf_lo(f1.y)); v[i][3] = (x[3] * ALPHA + bf_hi(pe.y)) + (bf_hi(f0.y) + bf_hi(f1.y)); }
        ln_row(v, g, b, F.lane);
        if (l == NL - 1 && !dummy) store_row(v, a->out + (size_t)m * DM, nullptr, F.lane); else store_row(v, nullptr, XB + (size_t)(dummy ? m & (T / 4 - 1) : m) * DM, F.lane); }
}
__device__ __forceinline__ void moe_info(Frame& F, int l) {
    LAS int* info = (LAS int*)(F.lds + LX_INFO);
    __syncthreads();
    if (F.tid == 0) { int base = 0;
        for (int e = 0; e < 16; ++e) { int c = (int)__hip_atomic_load(F.ctl + CW_CNT + (l * 16 + e) * 64, RLX_AGENT); c = c > 8192 ? 8192 : c; info[e] = c; info[16 + e] = base; base += (c + 255) >> 8; }
        info[32] = base; int x = 4 * base - 256; x = x < 0 ? 0 : (x > 256 ? 256 : x); info[33] = x; }
    LDS_WAIT(); __syncthreads();
}

constexpr int N_PHASES = 1 + NL * 8;
__global__ void __launch_bounds__(NWAVES * 64, 2) fwd_kernel(Args args) {
    extern __shared__ __attribute__((aligned(16))) unsigned char lds_raw[];
    Frame F;
    F.lds = (LAS unsigned char*)lds_raw; F.ws = nullptr; F.ctl = nullptr;
    F.tid = threadIdx.x; F.lane = F.tid & 63; F.wave = __builtin_amdgcn_readfirstlane(F.tid >> 6);
    F.G = gridDim.x; F.bx = blockIdx.x; F.vcu = (F.G % 8 == 0) ? (F.bx % 8) * (F.G / 8) + F.bx / 8 : F.bx;
    volatile LAS unsigned* MISC = (volatile LAS unsigned*)(F.lds + LX_MISC);
    for (int u = F.tid; u < (LDS_BYTES - LX_MISC) / 4; u += NWAVES * 64) MISC[u] = 0u;
    __syncthreads();
#if MK_ONE_LAUNCH
    XcdBarrier bar = xcd_barrier_post((unsigned*)(args.ws + WS_CTL) + CW_BAR, MISC + 8);
#define GRID_BAR() xcd_barrier(bar)
#else
#define GRID_BAR() do { } while (0)
#endif
    const int lo = args.ph_lo, hi = args.ph_hi;
#ifndef PH_MASK
#define PH_MASK 0x3ff
#endif
#define EN(s) ((PH_MASK >> (s)) & 1)
#ifndef PROBE_DUP
#define PROBE_DUP 0
#endif
#define REP(k) for (int rep_ = 0; rep_ < ((PROBE_DUP >> (k)) & 1) + 1; ++rep_)
#define IN(k) (lo <= (k) && (k) < hi)
#define BOTH(k) (IN(k) && IN((k) + 1))
#define PH_SETUP() KArgP ap = kargs(); unsigned char* ws = ap->ws; F.ws = ws; F.ctl = (unsigned*)(ws + WS_CTL); \
    { int tid_ = threadIdx.x, bx_ = blockIdx.x, g_ = gridDim.x; asm volatile("" : "+v"(tid_), "+s"(bx_), "+s"(g_)); F.tid = tid_; F.lane = tid_ & 63; F.wave = __builtin_amdgcn_readfirstlane(tid_ >> 6); \
      F.G = g_; F.bx = bx_; F.vcu = (g_ % 8 == 0) ? (bx_ % 8) * (g_ / 8) + bx_ / 8 : bx_; } \
    float* XF = (float*)(ws + WS_XF); bf16_t* XB = (bf16_t*)(ws + WS_XB); bf16_t* Qb = (bf16_t*)(ws + WS_Q); bf16_t* Kb = (bf16_t*)(ws + WS_K); bf16_t* Vb = (bf16_t*)(ws + WS_V); \
    bf16_t* UX = (bf16_t*)(ws + WS_UX); float* SS = (float*)(ws + WS_SS); bf16_t* CAT = (bf16_t*)(ws + WS_CAT); bf16_t* Yb = (bf16_t*)(ws + WS_Y); \
    float* SSQA = (float*)(ws + WS_SSQ); float* SSQS = SSQA + T * 8; bf16_t* PL = (bf16_t*)(ws + WS_PL); bf16_t* HID = (bf16_t*)(ws + WS_HID); bf16_t* FP = (bf16_t*)(ws + WS_FP); \
    const float* cosT = (const float*)(ws + WS_TAB); const float* sinT = cosT + SEQ * 64; unsigned char* wl = ws + WS_W + (size_t)l * WL_BYTES; \
    (void)XF; (void)XB; (void)Qb; (void)Kb; (void)Vb; (void)UX; (void)SS; (void)CAT; (void)Yb; (void)SSQA; (void)SSQS; (void)PL; (void)HID; (void)FP; (void)cosT; (void)sinT; (void)wl; (void)ap
    if (EN(0) && IN(0)) REP(0) { const int l = 0; PH_SETUP(); p0_prologue(ap, F); if (BOTH(0)) GRID_BAR(); }

    for (int l = 0; l < NL; ++l) {
        const int pb = 1 + l * 8;
        if (EN(1) && IN(pb + 0)) REP(1) { PH_SETUP();
            pg8::InProjSched S{(const char*)XB, (const char*)(wl + WL_IN), 0, F.G == 256 ? F.vcu : -1, (size_t)256 * DM * 2, (size_t)256 * DM * 2};
            pg8::EpiInProj<2> E{Qb, Kb, Vb, UX, ap->in[I_QG] + l * 128, ap->in[I_KG] + l * 128, cosT, sinT, (LAS float*)(F.lds + LX_P)};
            pg8::gemm_phase<pg8::EpiInProj<2>, pg8::InProjSched, true>(F.lds, DM, DM, S, E);
            if (BOTH(pb + 0)) GRID_BAR();
        }
        if (EN(2) && IN(pb + 1)) REP(2) { PH_SETUP();
            {
                pg8::InProjSched S{(const char*)XB, (const char*)(wl + WL_IN), 1, F.G == 256 ? F.vcu : -1, (size_t)256 * DM * 2, (size_t)256 * DM * 2};
                pg8::EpiInProj<1> E{Qb, Kb, Vb, UX, ap->in[I_QG] + l * 128, ap->in[I_KG] + l * 128, cosT, sinT, (LAS float*)(F.lds + LX_P)};
                REP(21) pg8::gemm_phase<pg8::EpiInProj<1>, pg8::InProjSched, true, true>(F.lds, DM, DM, S, E);
            }
            {
                const int loc_ = F.vcu & 31; const bool on = loc_ < 16 && F.G == 256;
                pg8::TileSched S2{(const char*)((const bf16_t*)(ws + WS_PB) + (size_t)l * T * PLE), (const char*)(wl + WL_PLE), T / 256, DM / 256, 128, on ? (F.vcu >> 5) * 16 + loc_ : (F.G == 256 ? -1 : F.vcu),
                                  (size_t)256 * PLE * 2, (size_t)256 * PLE * 2, false, 0, F.G == 256 ? 128 : 256};
                pg8::EpiBf16P8 E2{PL, DM};
                pg8::gemm_phase<pg8::EpiBf16P8, pg8::TileSched, true>(F.lds, PLE, PLE, S2, E2);
            }
            REP(11)
            {
                const int loc_ = F.vcu & 31; const bool act = loc_ >= 16 && F.G == 256;
                const int un = act ? (F.vcu >> 5) * 16 + (loc_ - 16) : 0, b = un >> 6, g = un & 63;
                const char* uxp = (const char*)(UX + (size_t)un * NCH * 512);
                float* sscr = SS + (size_t)un * 256 * 256;
                pg8::OneSched S1{uxp, (const char*)(wl + WL_S1) + (size_t)g * 256 * 256 * 2, b, g, act};
                pg8::EpiS1 E1{sscr};
                REP(18) pg8::gemm_phase<pg8::EpiS1, pg8::OneSched, true>(F.lds, 256, 512, S1, E1);
                VM_WAIT(); __syncthreads();
                REP(19) {
                    const int sg = F.tid >> 7, pr = F.tid & 127, d = pr >> 6, p = pr & 63; const size_t pi = ((size_t)(l * 2 + d) * NG + g) * NP + p;
                    float ar = 1.f, ai = 0.f;
                    if (act) { const float dt = expf(ap->in[I_LDT][(l * 2 + d) * NG + g]); const float zr = 16.f * dt * ap->in[I_ARE][pi], zi = 16.f * dt * ap->in[I_AIM][pi]; const float mg = expf(zr); ar = mg * cosf(zi); ai = mg * sinf(zi); }
                    const float* sre = sscr + d * 128 + p; LAS float* EX = (LAS float*)(F.lds + LX_P);
                    float xr = 0.f, xi = 0.f;
                    if (act) {
                        for (int cb = 0; cb < 64; cb += 16) { float sr[16], si[16];
#pragma unroll
                            for (int q = 0; q < 16; ++q) { const int qq = sg * 64 + cb + q, c = d == 0 ? qq : 255 - qq; sr[q] = sre[(size_t)c * 256]; si[q] = sre[(size_t)c * 256 + 64]; }
#pragma unroll
                            for (int q = 0; q < 16; ++q) { const float nr = ar * xr - ai * xi + sr[q], ni = ar * xi + ai * xr + si[q]; xr = nr; xi = ni; } }
                        EX[(sg * 128 + pr) * 2] = xr; EX[(sg * 128 + pr) * 2 + 1] = xi;
                    }
                    LDS_WAIT(); __syncthreads();
                    if (act) {
                        float br = ar, bi = ai;
#pragma unroll
                        for (int k = 0; k < 6; ++k) { const float t = br * br - bi * bi; bi = 2.f * br * bi; br = t; }
                        xr = 0.f; xi = 0.f;
                        for (int r = 0; r < sg; ++r) { const float er = EX[(r * 128 + pr) * 2], ei = EX[(r * 128 + pr) * 2 + 1]; const float nr = br * xr - bi * xi + er, ni = br * xi + bi * xr + ei; xr = nr; xi = ni; }
                        bf16_t* ux = UX + (size_t)un * NCH * 512 + 256 + d * 128 + p;
                        for (int cb = 0; cb < 64; cb += 16) { float sr[16], si[16];
#pragma unroll
                            for (int q = 0; q < 16; ++q) { const int qq = sg * 64 + cb + q, c = d == 0 ? qq : 255 - qq; sr[q] = sre[(size_t)c * 256]; si[q] = sre[(size_t)c * 256 + 64]; }
#pragma unroll
                            for (int q = 0; q < 16; ++q) { const int qq = sg * 64 + cb + q, c = d == 0 ? qq : 255 - qq;
                                ux[(size_t)c * 512] = (bf16_t)(cvt_pk_bf16(xr, xr) & 0xffffu); ux[(size_t)c * 512 + 64] = (bf16_t)(cvt_pk_bf16(xi, xi) & 0xffffu);
                                const float nr = ar * xr - ai * xi + sr[q], ni = ar * xi + ai * xr + si[q]; xr = nr; xi = ni; } }
                    }
                }
                VM_WAIT(); __syncthreads();
                pg8::OneSched S2{uxp, (const char*)(wl + WL_S2) + (size_t)g * 256 * 512 * 2, b, g, act};
                pg8::EpiS2 E2{Yb};
                REP(20) pg8::gemm_phase<pg8::EpiS2, pg8::OneSched, true>(F.lds, 512, 512, S2, E2);
            }
            if (BOTH(pb + 1)) GRID_BAR();
        }
        if (EN(3) && IN(pb + 2)) REP(3) { PH_SETUP();
            for (int un = F.vcu; un < 256; un += F.G) {
                const int bk = un >> 6, hl = (un >> 4) & 3, qb = un & 15, b = bk >> 1, kvh = bk & 1, h = kvh * 4 + hl;
                const size_t row0 = (size_t)b * SEQ + qb * 256;
                att::attn_dense_body(Qb + row0 * AW + h * 128, Kb + (size_t)b * SEQ * KVW + kvh * 128, Vb + (size_t)b * SEQ * KVW + kvh * 128,
                                     CAT + row0 * DM + h * 128, SSQA + row0 * 8 + h, SEQ, (char*)lds_raw);
            }
            {
            pg8::TileSched S{(const char*)Yb, (const char*)(wl + WL_GLU), T / 256, SW / 256, F.G, F.bx, (size_t)256 * SW * 2, (size_t)256 * SW * 2};
            pg8::EpiGlu E{Yb, ap->in[I_BGLU] + (size_t)l * SW, CAT, SSQS};
            pg8::gemm_phase<pg8::EpiGlu, pg8::TileSched, true>(F.lds, SW, SW, S, E);
            {
                const bool split = (F.G == 256);
                pg8::TileSched S2{(const char*)((const bf16_t*)(ws + WS_PB) + (size_t)l * T * PLE), (const char*)(wl + WL_PLE), T / 256, DM / 256, split ? 128 : F.G, split ? F.bx - 128 : -1,
                                  (size_t)256 * PLE * 2, (size_t)256 * PLE * 2, false, 128, 128};
                pg8::EpiBf16P8 E2{PL, DM};
                pg8::gemm_phase<pg8::EpiBf16P8, pg8::TileSched, true>(F.lds, PLE, PLE, S2, E2);
            }
            }
            if (BOTH(pb + 2)) GRID_BAR();
        }
        if (EN(5) && IN(pb + 3)) REP(5) { PH_SETUP();
            pg8::TileSched S{(const char*)CAT, (const char*)(wl + WL_OUT), T / 256, DM / 256, F.G, F.bx, (size_t)256 * DM * 2, (size_t)256 * DM * 2};
            LAS f32x2* st = (LAS f32x2*)(F.lds + LX_P);
            pg8::Unit u0; const bool have = S.next(0, u0); pg8::Unit u1; const bool more = S.next(1, u1); S.dup = (PROBE_DUP >> 17) & 1;
            __syncthreads();
            if (have && F.tid < 256) { const int row = u0.pm * 256 + F.tid; float sa = 0.f, ssum = 0.f;
#pragma unroll
                for (int k = 0; k < 8; ++k) sa += SSQA[(size_t)row * 8 + k];
#pragma unroll
                for (int k = 0; k < 16; ++k) ssum += SSQS[(size_t)row * 16 + k];
                const float ra = rsqrtf(sa * (1.f / AW) + EPS), rs = rsqrtf(ssum * (1.f / SW) + EPS); st[F.tid] = (f32x2){ra / rs, rs}; }
            LDS_WAIT(); __syncthreads();
            if (!more) {
                pg8::EpiOut E{(bf16_t*)(ws + WS_FP), st};
                pg8::gemm_phase<pg8::EpiOut, pg8::TileSched, true>(F.lds, DM, DM, S, E);
            } else if (F.tid == 0) { __hip_atomic_store(F.ctl + CW_TMO, 0x7f0u, RLX_AGENT); }
            if (BOTH(pb + 3)) GRID_BAR();
        }
        if (EN(6) && IN(pb + 4)) REP(6) { PH_SETUP(); ph_ln1(ap, F, l, (PROBE_DUP >> 6 & 1) && rep_ == 0); if (BOTH(pb + 4)) GRID_BAR(); }
        if (EN(7) && IN(pb + 5)) REP(7) { PH_SETUP();
            moe_info(F, l);
            int R0, C0, R1, C1; pg8::stage_rc(F.tid * 16, R0, C0); pg8::stage_rc(F.tid * 16 + 8192, R1, C1);
            pg8::MoeGuSched S{(const LAS int*)(F.lds + LX_INFO), (const char*)XB, (const char*)(wl + WL_GU), (const unsigned*)(ws + WS_LT) + (size_t)l * NE * 8192, F.G, F.vcu, R0, R1, (unsigned)C0 * 2u, (unsigned)C1 * 2u};
            pg8::EpiGu E{HID};
            REP(10) pg8::gemm_phase<pg8::EpiGu, pg8::MoeGuSched, true>(F.lds, DM, DM, S, E);
            const int xg = ((const LAS int*)(F.lds + LX_INFO))[33];
            pg8::PgSched S2{(const char*)XB, (const char*)(wl + WL_PG), 0, 256 - xg, F.vcu - xg, (size_t)256 * DM * 2, (size_t)256 * DM * 2};
            REP(12) { pg8::EpiPg E2{ap->in[I_BPG] + (size_t)l * DM, PL, UX};
            pg8::gemm_phase<pg8::EpiPg, pg8::PgSched, true>(F.lds, DM, DM, S2, E2); }
            if (BOTH(pb + 5)) GRID_BAR();
        }
        if (EN(8) && IN(pb + 6)) REP(8) { PH_SETUP();
            moe_info(F, l);
            const int xg = ((const LAS int*)(F.lds + LX_INFO))[33];
            {
                pg8::PgSched S2{(const char*)XB, (const char*)(wl + WL_PG), 256 - xg, xg, F.vcu, (size_t)256 * DM * 2, (size_t)256 * DM * 2};
                pg8::EpiPg E2{ap->in[I_BPG] + (size_t)l * DM, PL, UX};
                pg8::gemm_phase<pg8::EpiPg, pg8::PgSched, true>(F.lds, DM, DM, S2, E2);
            }
            pg8::MoeDnSched S{(const LAS int*)(F.lds + LX_INFO), (const char*)HID, (const char*)(wl + WL_DN), F.G - xg, F.vcu - xg};
            pg8::EpiDown E{FP, (const unsigned*)(ws + WS_LT) + (size_t)l * NE * 8192, (const float*)(ws + WS_LG) + (size_t)l * NE * 8192};
            pg8::gemm_phase<pg8::EpiDown, pg8::MoeDnSched, true>(F.lds, DE, DE, S, E);
            if (BOTH(pb + 6)) GRID_BAR();
        }
        if (EN(9) && IN(pb + 7)) REP(9) { PH_SETUP(); ph_comb(ap, F, l, (PROBE_DUP >> 9 & 1) && rep_ == 0); if (BOTH(pb + 7)) GRID_BAR(); }
    }
#undef IN
#undef BOTH
}

extern "C" void kernel_launch(void* const* d_in, const int* in_sizes, int n_in, void* d_out, int out_size, void* d_ws, size_t ws_size, hipStream_t stream) {
    static int grid = 0;
    if (grid == 0) {
        if (n_in != 34 || out_size != T * DM || ws_size < WS_END) { fprintf(stderr, "kernel_launch: unexpected shapes: n_in %d out %d ws %zu (need %zu)\n", n_in, out_size, ws_size, (size_t)WS_END); grid = -1; return; }
        int dev = 0, cus = 0, per_cu = 0;
        if (hipGetDevice(&dev) != hipSuccess || hipDeviceGetAttribute(&cus, hipDeviceAttributeMultiprocessorCount, dev) != hipSuccess) { grid = -1; return; }
        if (hipFuncSetAttribute((const void*)fwd_kernel, hipFuncAttributeMaxDynamicSharedMemorySize, LDS_BYTES) != hipSuccess) { fprintf(stderr, "kernel_launch: hipFuncSetAttribute failed\n"); grid = -1; return; }
        if (hipOccupancyMaxActiveBlocksPerMultiprocessor(&per_cu, (const void*)fwd_kernel, NWAVES * 64, LDS_BYTES) != hipSuccess || per_cu < 1) fprintf(stderr, "kernel_launch: occupancy query reports %d\n", per_cu);
        (void)hipGetLastError();
        grid = cus;
        if (grid != 256) fprintf(stderr, "kernel_launch: %d CUs; this kernel is built for 256\n", grid);
    }
    if (grid < 0) return;
    (void)hipMemsetAsync((char*)d_ws + WS_CTL, 0, CTL_ZERO_BYTES, stream);
    Args a{};
    for (int i = 0; i < 34; ++i) a.in[i] = (const float*)d_in[i];
    a.out = (float*)d_out; a.ws = (unsigned char*)d_ws;
#if MK_ONE_LAUNCH
    a.ph_lo = 0; a.ph_hi = N_PHASES;
    hipLaunchKernelGGL(fwd_kernel, dim3(grid), dim3(NWAVES * 64), LDS_BYTES, stream, a);
#else
    for (int ph = 0; ph < N_PHASES; ++ph) { a.ph_lo = ph; a.ph_hi = ph + 1; hipLaunchKernelGGL(fwd_kernel, dim3(grid), dim3(NWAVES * 64), LDS_BYTES, stream, a); }
#endif
    const hipError_t le = hipPeekAtLastError();
    if (le != hipSuccess) fprintf(stderr, "kernel_launch: launch failed: %s\n", hipGetErrorName(le));
}
```
